# Optimizing an MI355X kernel written in HIP

```python
import math
import jax, jax.numpy as jnp
from jax import lax
import numpy as np

D_MODEL = 1024
BATCH = 2
SEQ = 16384
DEPTH = 2

CHUNK = 64
Q_BLOCK = 128
A_HEADS = 8
A_HEAD_DIM = 64
A_WIDTH = A_HEADS * A_HEAD_DIM
IDX_HEADS = 8
IDX_DIM = 64
TOPK_MAX = 256
B_HEADS = 8
B_Q_LORA = 384
B_KV_LORA = 256
B_NOPE = 64
B_ROPE = 32
B_QK = B_NOPE + B_ROPE
B_V = 64
B_WIDTH = B_HEADS * B_V
ROPE_BASE = 10000.0
REL_BUCKETS = 32
REL_MAX_DIST = 128
D_FF = 2816
CONV_W = 3
EPS = 1e-6

IN_SIZES = (A_WIDTH, A_WIDTH, A_WIDTH,
            IDX_HEADS * IDX_DIM, IDX_DIM, IDX_HEADS,
            B_Q_LORA, B_KV_LORA, B_ROPE,
            D_MODEL, D_MODEL)
IN_COLS = 3 * A_WIDTH + IDX_HEADS * IDX_DIM + IDX_DIM + IDX_HEADS + B_Q_LORA + B_KV_LORA + B_ROPE + 2 * D_MODEL

kernel_name = "hybrid_dsa_mla_convffn_chunk_causal"


def rms_norm(x, g):
    xf = x.astype(jnp.float32)
    y = xf * lax.rsqrt(jnp.mean(xf * xf, axis=-1, keepdims=True) + EPS)
    return (y * g.astype(jnp.float32)).astype(x.dtype)


def split_cols(z):
    out, start = [], 0
    for n in IN_SIZES:
        out.append(z[..., start:start + n])
        start += n
    return out


def rope(x, pos):
    half = x.shape[-1] // 2
    inv = ROPE_BASE ** (-jnp.arange(half, dtype=jnp.float32) / half)
    ang = pos.astype(jnp.float32)[:, None] * inv[None, :]
    cos = jnp.cos(ang)[:, None, :]
    sin = jnp.sin(ang)[:, None, :]
    xf = x.astype(jnp.float32)
    x1, x2 = xf[..., :half], xf[..., half:]
    return jnp.concatenate([x1 * cos - x2 * sin, x1 * sin + x2 * cos], axis=-1).astype(x.dtype)


def t5_bucket(rel):
    nb = REL_BUCKETS // 2
    max_exact = nb // 2
    side = jnp.where(rel > 0, nb, 0)
    n = jnp.abs(rel)
    nf = jnp.maximum(n, 1).astype(jnp.float32)
    large = max_exact + (jnp.log(nf / max_exact) / math.log(REL_MAX_DIST / max_exact)
                         * (nb - max_exact)).astype(jnp.int32)
    large = jnp.minimum(large, nb - 1)
    return side + jnp.where(n < max_exact, n, large)


def sparse_indexed_attention(q, k, v, q_idx, k_idx, w_idx, rel_bias, topk):
    B, S = q.shape[0], q.shape[1]
    n_blk = S // Q_BLOCK
    key_chunk = jnp.arange(S, dtype=jnp.int32) // CHUNK
    bidx = jnp.arange(B)[:, None, None]
    scale = A_HEAD_DIM ** -0.5
    idx_scale = (IDX_HEADS ** -0.5) * (IDX_DIM ** -0.5)

    def block(i):
        t0 = i * Q_BLOCK
        tq = t0 + jnp.arange(Q_BLOCK, dtype=jnp.int32)
        qi = lax.dynamic_slice_in_dim(q_idx, t0, Q_BLOCK, axis=1)
        wi = lax.dynamic_slice_in_dim(w_idx, t0, Q_BLOCK, axis=1).astype(jnp.float32)
        rel = jax.nn.relu(jnp.einsum('bthd,bsd->bths', qi, k_idx).astype(jnp.float32))
        score = jnp.einsum('bths,bth->bts', rel, wi) * idx_scale
        admissible = key_chunk[None, :] <= (tq // CHUNK)[:, None]
        score = jnp.where(admissible[None], score, -jnp.inf)
        _, sel = lax.top_k(score, topk)
        valid = (sel // CHUNK) <= (tq // CHUNK)[None, :, None]
        k_sel = k[bidx, sel]
        v_sel = v[bidx, sel]
        qb = lax.dynamic_slice_in_dim(q, t0, Q_BLOCK, axis=1)
        logits = jnp.einsum('bthd,btkhd->bthk', qb, k_sel).astype(jnp.float32) * scale
        bias = rel_bias[t5_bucket(sel - tq[None, :, None])]
        logits = logits + jnp.moveaxis(bias, -1, 2).astype(jnp.float32)
        logits = jnp.where(valid[:, :, None, :], logits, -jnp.inf)
        p = jax.nn.softmax(logits, axis=-1).astype(v.dtype)
        return jnp.einsum('bthk,btkhd->bthd', p, v_sel)

    out = lax.map(block, jnp.arange(n_blk))
    return jnp.moveaxis(out, 0, 1).reshape(B, S, A_WIDTH)


def latent_attention(q, k, v):
    B, S = q.shape[0], q.shape[1]
    n_blk = S // Q_BLOCK
    key_chunk = jnp.arange(S, dtype=jnp.int32) // CHUNK
    scale = B_QK ** -0.5

    def block(i):
        t0 = i * Q_BLOCK
        tq = t0 + jnp.arange(Q_BLOCK, dtype=jnp.int32)
        qb = lax.dynamic_slice_in_dim(q, t0, Q_BLOCK, axis=1)
        logits = jnp.einsum('bthd,bshd->bhts', qb, k).astype(jnp.float32) * scale
        mask = key_chunk[None, :] <= (tq // CHUNK)[:, None]
        logits = jnp.where(mask[None, None], logits, -jnp.inf)
        p = jax.nn.softmax(logits, axis=-1).astype(v.dtype)
        return jnp.einsum('bhts,bshd->bthd', p, v)

    out = lax.map(block, jnp.arange(n_blk))
    return jnp.moveaxis(out, 0, 1).reshape(B, S, B_WIDTH)


def causal_dwconv(u, w, b):
    S = u.shape[1]
    up = jnp.pad(u, ((0, 0), (CONV_W - 1, 0), (0, 0)))
    acc = b
    for j in range(CONV_W):
        acc = acc + w[j] * up[:, j:j + S]
    return acc


def setup_inputs(seed: int = 0) -> dict:
    key = jax.random.key(seed)
    ks = jax.random.split(key, 22)
    f32 = jnp.float32
    L = DEPTH

    def lin(k, shape, fan_in):
        return jax.random.normal(k, shape, f32) * fan_in ** -0.5

    def gain(k, shape):
        return 1.0 + 0.02 * jax.random.normal(k, shape, f32)

    return {
        "x": jax.random.normal(ks[0], (BATCH, SEQ, D_MODEL), f32),
        "rel_bias": 0.1 * jax.random.normal(ks[1], (REL_BUCKETS, A_HEADS), f32),
        "norm_mix": gain(ks[2], (L, D_MODEL)),
        "w_in": lin(ks[3], (L, D_MODEL, IN_COLS), D_MODEL),
        "a_q_norm": gain(ks[4], (L, A_HEAD_DIM)),
        "a_k_norm": gain(ks[5], (L, A_HEAD_DIM)),
        "b_cq_norm": gain(ks[6], (L, B_Q_LORA)),
        "b_ckv_norm": gain(ks[7], (L, B_KV_LORA)),
        "b_w_uq": lin(ks[8], (L, B_Q_LORA, B_HEADS * B_QK), B_Q_LORA),
        "b_w_ukv": lin(ks[9], (L, B_KV_LORA, B_HEADS * (B_NOPE + B_V)), B_KV_LORA),
        "b_q_norm": gain(ks[10], (L, B_QK)),
        "b_k_norm": gain(ks[11], (L, B_QK)),
        "w_proj_a": lin(ks[12], (L, A_WIDTH, D_MODEL), A_WIDTH),
        "w_proj_b": lin(ks[13], (L, B_WIDTH, D_MODEL), B_WIDTH),
        "b_gate": 0.01 * jax.random.normal(ks[14], (L, 2 * D_MODEL), f32),
        "w_out": lin(ks[15], (L, D_MODEL, D_MODEL), D_MODEL),
        "norm_ffn": gain(ks[16], (L, D_MODEL)),
        "w_up": lin(ks[17], (L, D_MODEL, 2 * D_FF), D_MODEL),
        "conv_w": lin(ks[18], (L, CONV_W, 2 * D_FF), CONV_W),
        "conv_b": 0.01 * jax.random.normal(ks[19], (L, 2 * D_FF), f32),
        "w_down": lin(ks[20], (L, D_FF, D_MODEL), D_FF),
    }


def reference(x, rel_bias, norm_mix, w_in, a_q_norm, a_k_norm, b_cq_norm, b_ckv_norm,
              b_w_uq, b_w_ukv, b_q_norm, b_k_norm, w_proj_a, w_proj_b, b_gate, w_out,
              norm_ffn, w_up, conv_w, conv_b, w_down):
    B, S, _ = x.shape
    topk = min(TOPK_MAX, S // 4)
    pos = jnp.arange(S, dtype=jnp.int32)
    for l in range(DEPTH):
        h = rms_norm(x, norm_mix[l])
        z = h @ w_in[l]
        qa, ka, va, qi, ki, wi, cq, ckv, kr, ga, gb = split_cols(z)

        qa = rms_norm(qa.reshape(B, S, A_HEADS, A_HEAD_DIM), a_q_norm[l])
        ka = rms_norm(ka.reshape(B, S, A_HEADS, A_HEAD_DIM), a_k_norm[l])
        va = va.reshape(B, S, A_HEADS, A_HEAD_DIM)
        qi = qi.reshape(B, S, IDX_HEADS, IDX_DIM)
        y_a = sparse_indexed_attention(qa, ka, va, qi, ki, wi, rel_bias, topk)

        cq = rms_norm(cq, b_cq_norm[l])
        qb = (cq @ b_w_uq[l]).reshape(B, S, B_HEADS, B_QK)
        qb = jnp.concatenate([qb[..., :B_NOPE], rope(qb[..., B_NOPE:], pos)], axis=-1)
        ckv = rms_norm(ckv, b_ckv_norm[l])
        kv = (ckv @ b_w_ukv[l]).reshape(B, S, B_HEADS, B_NOPE + B_V)
        k_rope = jnp.broadcast_to(rope(kr[:, :, None, :], pos), (B, S, B_HEADS, B_ROPE))
        kb = jnp.concatenate([kv[..., :B_NOPE], k_rope], axis=-1)
        vb = kv[..., B_NOPE:]
        qb = rms_norm(qb, b_q_norm[l])
        kb = rms_norm(kb, b_k_norm[l])
        y_b = latent_attention(qb, kb, vb)

        gate_a = jax.nn.sigmoid(ga + b_gate[l, :D_MODEL])
        gate_b = jax.nn.sigmoid(gb + b_gate[l, D_MODEL:])
        merged = gate_a * (y_a @ w_proj_a[l]) + gate_b * (y_b @ w_proj_b[l])
        x = x + merged @ w_out[l]

        h = rms_norm(x, norm_ffn[l])
        u = causal_dwconv(h @ w_up[l], conv_w[l], conv_b[l])
        val, gat = u[..., :D_FF], u[..., D_FF:]
        x = x + (jax.nn.silu(gat) * val) @ w_down[l]
    return x
```

```cpp
#include <hip/hip_runtime.h>
#include <hip/hip_cooperative_groups.h>
#include <cstdio>
namespace cg = cooperative_groups;

#ifndef MULTI_LAUNCH
#define MULTI_LAUNCH 0
#endif

typedef __bf16 bf16;
using bf16x8 = __attribute__((ext_vector_type(8))) __bf16;
using bf16x2 = __attribute__((ext_vector_type(2))) __bf16;
using f16x8  = __attribute__((ext_vector_type(8))) _Float16;
using f32x16 = __attribute__((ext_vector_type(16))) float;
using f32x4  = __attribute__((ext_vector_type(4))) float;
using f32x2  = __attribute__((ext_vector_type(2))) float;
using u32x4  = __attribute__((ext_vector_type(4))) unsigned;
using u32x2  = __attribute__((ext_vector_type(2))) unsigned;
using u32x8  = __attribute__((ext_vector_type(8))) unsigned;
#define DI __device__ __forceinline__

constexpr int T_ = 32768, S_ = 16384, DM = 1024;
constexpr int ZLD = 2816;
constexpr int C_QA = 0, C_KA = 512, C_VA = 1024, C_QI = 1536, C_KI = 2048, C_WI = 2112, C_CQ = 2120, C_CKV = 2504, C_KR = 2760;
constexpr int INC = 4840, C_GA = 2792, C_GB = 3816;
constexpr int DFF = 2816;
constexpr float EPS = 1e-6f;
constexpr float LOG2E = 1.4426950408889634f;

constexpr size_t WO_IN = 0;
constexpr size_t WO_UQ = WO_IN + (size_t)INC * 1024;
constexpr size_t WO_UKV = WO_UQ + 768 * 384;
constexpr size_t WO_PA = WO_UKV + 1024 * 256;
constexpr size_t WO_PB = WO_PA + 1024 * 512;
constexpr size_t WO_OUT = WO_PB + 1024 * 512;
constexpr size_t WO_UP = WO_OUT + 1024 * 1024;
constexpr size_t WO_DOWN = WO_UP + (size_t)5632 * 1024;
constexpr size_t W_LAYER = WO_DOWN + (size_t)1024 * 2816;

constexpr size_t MiB = 1048576;
constexpr size_t OFF_WT = 0;
constexpr size_t OFF_HN = 63 * MiB;
constexpr size_t OFF_MASK = 127 * MiB;
constexpr size_t OFF_Z = 160 * MiB;
constexpr size_t OFF_QB = 336 * MiB;
constexpr size_t OFF_KB = 384 * MiB;
constexpr size_t OFF_VTA = 432 * MiB;
constexpr size_t OFF_VTB = 464 * MiB;
constexpr size_t OFF_BAR = 500 * MiB;
constexpr size_t OFF_CTR = 500 * MiB + 16384;
constexpr size_t OFF_ZPAGE = 500 * MiB + 32768;
constexpr size_t MASK_WORDS_B = 4210688;
constexpr size_t MASK_BYTES = MASK_WORDS_B * 2 * 4;

struct Params {
  const float* x; const float* rel_bias; const float* norm_mix; const float* w_in; const float* a_q_norm; const float* a_k_norm;
  const float* b_cq_norm; const float* b_ckv_norm; const float* b_w_uq; const float* b_w_ukv; const float* b_q_norm; const float* b_k_norm;
  const float* w_proj_a; const float* w_proj_b; const float* b_gate; const float* w_out; const float* norm_ffn; const float* w_up;
  const float* conv_w; const float* conv_b; const float* w_down;
  float* out; char* ws;
};

DI int ltid() { int t = threadIdx.x; asm volatile("" : "+v"(t)); return t; }
DI unsigned short f2bf(float f) { return __builtin_bit_cast(unsigned short, (__bf16)f); }
DI unsigned pk2(float a, float b) { f32x2 v = {a, b}; return __builtin_bit_cast(unsigned, __builtin_convertvector(v, bf16x2)); }
DI float bf2f(unsigned short u) { return __uint_as_float(((unsigned)u) << 16); }
DI float bflo(unsigned u) { return __uint_as_float(u << 16); }
DI float bfhi(unsigned u) { return __uint_as_float(u & 0xffff0000u); }
DI unsigned short f2h(float f) { return __builtin_bit_cast(unsigned short, (_Float16)f); }
DI float wave_sum(float v) {
#pragma unroll
  for (int o = 32; o >= 1; o >>= 1) v += __shfl_xor(v, o);
  return v;
}
template <class T> DI T* uoff(T* base, unsigned byteoff) { return (T*)((char*)base + byteoff); }
template <class T> DI const T* uoff(const T* base, unsigned byteoff) { return (const T*)((const char*)base + byteoff); }
DI int xcd_tile(int t, int total) {
  const int local = t >> 3, l = local & 63;
  const int nl = (local & ~63) | (((l & 31) << 1) | (l >> 5));
  const int chunk = total >> 3;
  return (t & 7) * chunk + (((local | 63) < chunk) ? nl : local);
}
DI int mask_base(int b, int c) { return b * (int)MASK_WORDS_B + c * (c + 1) * 64; }

constexpr int STAGE_B = 32768;
#define WAIT_V0() asm volatile("s_waitcnt vmcnt(0)" ::: "memory")
DI void gemm_core(char* smem, int nk, const char* Ab, const char* Bb, const unsigned (&aoff)[4], const unsigned (&boff)[4],
                  f32x16 (&acc)[2][2]) {
  const int tid = ltid(), lane = tid & 63, w = tid >> 6;
  const int wm = w >> 1, wn = w & 1;
#pragma unroll
  for (int mb = 0; mb < 2; ++mb)
#pragma unroll
    for (int nb = 0; nb < 2; ++nb)
#pragma unroll
      for (int i = 0; i < 16; ++i) acc[mb][nb][i] = 0.f;
  const int l31 = lane & 31, H = lane >> 5, x = (l31 >> 1) & 7;
  const int a_base = (wm * 64 + l31) * 128, b_base = 16384 + (wn * 64 + l31) * 128;
  int xo[4];
#pragma unroll
  for (int ks = 0; ks < 4; ++ks) xo[ks] = ((2 * ks + H) ^ x) << 4;
  auto stage = [&](int buf, int kt) __attribute__((always_inline)) {
    const char* ak = Ab + kt * 128;
    const char* bk = Bb + kt * 128;
    char* sa = smem + buf * STAGE_B + w * 4096;
#pragma unroll
    for (int i = 0; i < 4; ++i) {
      __builtin_amdgcn_global_load_lds((const unsigned*)(ak + aoff[i]), (unsigned*)(sa + i * 1024), 16, 0, 0);
      __builtin_amdgcn_global_load_lds((const unsigned*)(bk + boff[i]), (unsigned*)(sa + 16384 + i * 1024), 16, 0, 0);
    }
  };
  stage(0, 0);
  WAIT_V0();
  __syncthreads();
  for (int kt = 0; kt < nk; ++kt) {
    const int cur = kt & 1;
    if (kt + 1 < nk) stage(cur ^ 1, kt + 1);
    const char* sb = smem + cur * STAGE_B;
#pragma unroll
    for (int ks = 0; ks < 4; ++ks) {
      bf16x8 af[2], bfr[2];
#pragma unroll
      for (int mb = 0; mb < 2; ++mb) af[mb] = *(const bf16x8*)(sb + a_base + mb * 4096 + xo[ks]);
#pragma unroll
      for (int nb = 0; nb < 2; ++nb) bfr[nb] = *(const bf16x8*)(sb + b_base + nb * 4096 + xo[ks]);
#pragma unroll
      for (int mb = 0; mb < 2; ++mb)
#pragma unroll
        for (int nb = 0; nb < 2; ++nb)
          acc[mb][nb] = __builtin_amdgcn_mfma_f32_32x32x16_bf16(af[mb], bfr[nb], acc[mb][nb], 0, 0, 0);
    }
    WAIT_V0();
    __syncthreads();
  }
}

DI int glds_row(int i) { const int tid = ltid(); return ((tid >> 6) * 4 + i) * 8 + ((tid & 63) >> 3); }
DI int glds_chunk(int row) { return (ltid() & 7) ^ ((row >> 1) & 7); }

template <class F>
DI void epi_foreach(const f32x16 (&acc)[2][2], F f) {
  const int lane = ltid() & 63, w = ltid() >> 6;
  const int wm = w >> 1, wn = w & 1;
#pragma unroll
  for (int mb = 0; mb < 2; ++mb)
#pragma unroll
    for (int nb = 0; nb < 2; ++nb)
#pragma unroll
      for (int r = 0; r < 16; ++r) {
        const int row = wm * 64 + mb * 32 + (r & 3) + 8 * (r >> 2) + 4 * (lane >> 5);
        const int col = wn * 64 + nb * 32 + (lane & 31);
        f(row, col, acc[mb][nb][r]);
        if ((r & 7) == 7) __builtin_amdgcn_sched_barrier(0);
      }
}

DI void store_tile16(const unsigned short* Cs, unsigned short* dst, int ldd) {
  const int tid = ltid();
#pragma unroll
  for (int i = 0; i < 8; ++i) {
    const int idx = tid + 256 * i;
    const int row = idx >> 4, c8 = (idx & 15) * 8;
    *(u32x4*)(dst + (size_t)row * ldd + c8) = *(const u32x4*)(Cs + row * 136 + c8);
  }
}

DI void gemm_tile(char* smem, int nk, const bf16* A, int lda, int m0, const bf16* Bt, int ldb, int n0, f32x16 (&acc)[2][2]) {
  unsigned aoff[4], boff[4];
#pragma unroll
  for (int i = 0; i < 4; ++i) {
    const int row = glds_row(i), ch = glds_chunk(row);
    aoff[i] = (unsigned)((row * lda + ch * 8) * 2);
    boff[i] = (unsigned)((row * ldb + ch * 8) * 2);
  }
  gemm_core(smem, nk, (const char*)(A + (size_t)m0 * lda), (const char*)(Bt + (size_t)n0 * ldb), aoff, boff, acc);
}

DI void transpose_tile(const float* src, bf16* dst, int K, int N, int t, char* smem) {
  unsigned short* ts = (unsigned short*)smem;
  const int tid = ltid();
  const int ntn = (N + 63) >> 6;
  const int n0 = (t % ntn) * 64, k0 = (t / ntn) * 64;
  {
    const int n4 = (tid & 15) * 4, kb = tid >> 4;
#pragma unroll
    for (int i = 0; i < 4; ++i) {
      const int k = kb + 16 * i;
      float4 v = {0.f, 0.f, 0.f, 0.f};
      if (n0 + n4 < N) v = *(const float4*)(src + (size_t)(k0 + k) * N + n0 + n4);
      ts[(n4 + 0) * 66 + k] = f2bf(v.x); ts[(n4 + 1) * 66 + k] = f2bf(v.y);
      ts[(n4 + 2) * 66 + k] = f2bf(v.z); ts[(n4 + 3) * 66 + k] = f2bf(v.w);
    }
  }
  __syncthreads();
  {
    const int n = tid >> 2, kc = tid & 3;
    if (n0 + n < N) {
      const unsigned* rp = (const unsigned*)(ts + n * 66 + kc * 16);
      u32x4 a = {rp[0], rp[1], rp[2], rp[3]}, b = {rp[4], rp[5], rp[6], rp[7]};
      u32x4* dp = (u32x4*)(dst + (size_t)(n0 + n) * K + k0 + kc * 16);
      dp[0] = a; dp[1] = b;
    }
  }
  __syncthreads();
}

DI void phase_convert(const Params& P, char* smem) {
  bf16* wt = (bf16*)(P.ws + OFF_WT);
  constexpr int NW = 8;
  const int Ks[NW] = {1024, 384, 256, 512, 512, 1024, 1024, 2816};
  const int Ns[NW] = {INC, 768, 1024, 1024, 1024, 1024, 5632, 1024};
  int total = 0;
#pragma unroll
  for (int i = 0; i < NW; ++i) total += ((Ns[i] + 63) >> 6) * (Ks[i] >> 6);
  for (int t = blockIdx.x; t < 2 * total; t += gridDim.x) {
    const int l = t >= total ? 1 : 0;
    int r = t - l * total;
    bf16* wl = wt + l * W_LAYER;
    const float* src = nullptr; bf16* dst = nullptr; int K = 64, N = 64;
    bool found = false;
#pragma unroll
    for (int i = 0; i < NW; ++i) {
      const int nt = ((Ns[i] + 63) >> 6) * (Ks[i] >> 6);
      if (!found && r < nt) {
        found = true; K = Ks[i]; N = Ns[i];
        const size_t lo = (size_t)l * Ks[i] * Ns[i];
        src = (i == 0 ? P.w_in : i == 1 ? P.b_w_uq : i == 2 ? P.b_w_ukv : i == 3 ? P.w_proj_a : i == 4 ? P.w_proj_b : i == 5 ? P.w_out : i == 6 ? P.w_up : P.w_down) + lo;
        dst = wl + (i == 0 ? WO_IN : i == 1 ? WO_UQ : i == 2 ? WO_UKV : i == 3 ? WO_PA : i == 4 ? WO_PB : i == 5 ? WO_OUT : i == 6 ? WO_UP : WO_DOWN);
      }
      if (!found) r -= nt;
    }
    transpose_tile(src, dst, K, N, r, smem);
  }
}

DI void phase_rmsnorm(const float* x, const float* g, bf16* hn) {
  const int lane = ltid() & 63, w = ltid() >> 6;
  for (int t = blockIdx.x * 4 + w; t < T_; t += gridDim.x * 4) {
    const float4* xr = (const float4*)(x + (size_t)t * DM);
    float4 v[4];
    float ss = 0.f;
#pragma unroll
    for (int i = 0; i < 4; ++i) {
      v[i] = xr[lane + 64 * i];
      ss += v[i].x * v[i].x + v[i].y * v[i].y + v[i].z * v[i].z + v[i].w * v[i].w;
    }
    ss = wave_sum(ss);
    const float r = rsqrtf(ss * (1.f / DM) + EPS);
#pragma unroll
    for (int i = 0; i < 4; ++i) {
      const float4 gg = ((const float4*)g)[lane + 64 * i];
      u32x2 o;
      o.x = pk2(v[i].x * r * gg.x, v[i].y * r * gg.y);
      o.y = pk2(v[i].z * r * gg.z, v[i].w * r * gg.w);
      *(u32x2*)(hn + (size_t)t * DM + (lane + 64 * i) * 4) = o;
    }
  }
}

DI void phase_zero_mask(const Params& P) {
  u32x4* m = (u32x4*)(P.ws + OFF_MASK);
  const size_t n = MASK_BYTES / 16;
  const u32x4 z = {0u, 0u, 0u, 0u};
  for (size_t i = (size_t)blockIdx.x * 256 + ltid(); i < n; i += (size_t)gridDim.x * 256) m[i] = z;
}

DI void phase_gemm_in(const Params& P, int layer, char* smem) {
  const bf16* hn = (const bf16*)(P.ws + OFF_HN);
  const bf16* wt = (const bf16*)(P.ws + OFF_WT) + layer * W_LAYER + WO_IN;
  unsigned short* Z = (unsigned short*)(P.ws + OFF_Z);
  constexpr int NT = 22, MT = 256;
  for (int t0 = blockIdx.x; t0 < NT * MT; t0 += gridDim.x) {
    const int tl = xcd_tile(t0, NT * MT) - (t0 & 7) * ((NT * MT) >> 3);
    const int m0 = ((t0 & 3) * 64 + tl / 11) * 128, n0 = (((t0 & 7) >> 2) * 11 + tl % 11) * 128;
    f32x16 acc[2][2];
    gemm_tile(smem, 16, hn, 1024, m0, wt, 1024, n0, acc);
    unsigned short* Cs = (unsigned short*)smem;
    epi_foreach(acc, [&](int row, int col, float v) __attribute__((always_inline)) {
      const int c = n0 + col;
      Cs[row * 136 + col] = (c >= C_QI && c < C_CQ) ? f2h(v) : f2bf(v);
    });
    __syncthreads();
    store_tile16(Cs, Z + (size_t)m0 * ZLD + n0, ZLD);
    __syncthreads();
  }
}

DI void transpose_v(const unsigned short* src, int ld, int col0, int hs, unsigned short* dst, char* smem) {
  unsigned short* ts = (unsigned short*)smem;
  const int tid = ltid();
  const int nitems = (T_ / 64) * 8;
  for (int it = blockIdx.x; it < nitems; it += gridDim.x) {
    const int h = it & 7, tg = it >> 3;
    const int t0 = tg * 64;
#pragma unroll
    for (int i = 0; i < 2; ++i) {
      const int r = (tid >> 3) + 32 * i, ch = tid & 7;
      u32x4 v = *(const u32x4*)(src + (size_t)(t0 + r) * ld + col0 + h * hs + ch * 8);
      *(u32x4*)(ts + r * 72 + ch * 8) = v;
    }
    __syncthreads();
    const int b = t0 / S_, s0 = t0 % S_;
#pragma unroll
    for (int i = 0; i < 2; ++i) {
      const int dv = (tid >> 3) + 32 * i, c = tid & 7;
      unsigned short e[8];
#pragma unroll
      for (int j = 0; j < 8; ++j) e[j] = ts[(8 * c + j) * 72 + dv];
      u32x4 o;
      o.x = e[0] | ((unsigned)e[1] << 16); o.y = e[2] | ((unsigned)e[3] << 16);
      o.z = e[4] | ((unsigned)e[5] << 16); o.w = e[6] | ((unsigned)e[7] << 16);
      *(u32x4*)(dst + ((size_t)((b * 8 + h) * 64 + dv)) * S_ + s0 + 8 * c) = o;
    }
    __syncthreads();
  }
}

DI void phase_token_a(const Params& P, int layer, char* smem) {
  unsigned short* Z = (unsigned short*)(P.ws + OFF_Z);
  const int lane = ltid() & 63, w = ltid() >> 6;
  const float* gq = P.a_q_norm + layer * 64;
  const float* gk = P.a_k_norm + layer * 64;
  const float* gcq = P.b_cq_norm + layer * 384;
  const float* gckv = P.b_ckv_norm + layer * 256;
  for (int t = blockIdx.x * 4 + w; t < T_; t += gridDim.x * 4) {
    unsigned short* zr = Z + (size_t)t * ZLD;
#pragma unroll
    for (int which = 0; which < 2; ++which) {
      const float* g = which ? gk : gq;
      u32x4* p = (u32x4*)(zr + (which ? C_KA : C_QA) + lane * 8);
      u32x4 u = *p;
      float f[8] = {bflo(u.x), bfhi(u.x), bflo(u.y), bfhi(u.y), bflo(u.z), bfhi(u.z), bflo(u.w), bfhi(u.w)};
      float ss = 0.f;
#pragma unroll
      for (int j = 0; j < 8; ++j) ss += f[j] * f[j];
      ss += __shfl_xor(ss, 1); ss += __shfl_xor(ss, 2); ss += __shfl_xor(ss, 4);
      const float r = rsqrtf(ss * (1.f / 64) + EPS);
      const int c0 = (lane & 7) * 8;
#pragma unroll
      for (int j = 0; j < 8; ++j) f[j] = f[j] * r * g[c0 + j];
      u.x = pk2(f[0], f[1]); u.y = pk2(f[2], f[3]); u.z = pk2(f[4], f[5]); u.w = pk2(f[6], f[7]);
      *p = u;
    }
    {
      unsigned* p = (unsigned*)(zr + C_CQ + lane * 6);
      unsigned u0 = p[0], u1 = p[1], u2 = p[2];
      float f[6] = {bflo(u0), bfhi(u0), bflo(u1), bfhi(u1), bflo(u2), bfhi(u2)};
      float ss = 0.f;
#pragma unroll
      for (int j = 0; j < 6; ++j) ss += f[j] * f[j];
      ss = wave_sum(ss);
      const float r = rsqrtf(ss * (1.f / 384) + EPS);
#pragma unroll
      for (int j = 0; j < 6; ++j) f[j] = f[j] * r * gcq[lane * 6 + j];
      p[0] = pk2(f[0], f[1]); p[1] = pk2(f[2], f[3]); p[2] = pk2(f[4], f[5]);
    }
    {
      u32x2* p = (u32x2*)(zr + C_CKV + lane * 4);
      u32x2 u = *p;
      float f[4] = {bflo(u.x), bfhi(u.x), bflo(u.y), bfhi(u.y)};
      float ss = f[0] * f[0] + f[1] * f[1] + f[2] * f[2] + f[3] * f[3];
      ss = wave_sum(ss);
      const float r = rsqrtf(ss * (1.f / 256) + EPS);
#pragma unroll
      for (int j = 0; j < 4; ++j) f[j] = f[j] * r * gckv[lane * 4 + j];
      u.x = pk2(f[0], f[1]); u.y = pk2(f[2], f[3]);
      *p = u;
    }
    {
      const int i = lane & 15;
      const float x1 = bf2f(zr[C_KR + i]), x2 = bf2f(zr[C_KR + 16 + i]);
      const float inv = powf(10000.f, -(float)i / 16.f);
      const float ang = (float)(t % S_) * inv;
      float sn, cs;
      sincosf(ang, &sn, &cs);
      const float o1 = x1 * cs - x2 * sn, o2 = x1 * sn + x2 * cs;
      if (lane < 16) { zr[C_KR + i] = f2bf(o1); zr[C_KR + 16 + i] = f2bf(o2); }
    }
  }
  __syncthreads();
  transpose_v(Z, ZLD, C_VA, 64, (unsigned short*)(P.ws + OFF_VTA), smem);
}

DI void phase_gemm_lat(const Params& P, int layer, char* smem) {
  const bf16* Z = (const bf16*)(P.ws + OFF_Z);
  const bf16* wl = (const bf16*)(P.ws + OFF_WT) + layer * W_LAYER;
  unsigned short* QB = (unsigned short*)(P.ws + OFF_QB);
  unsigned short* KV = (unsigned short*)(P.ws + OFF_HN);
  constexpr int MT = 256;
  for (int t0 = blockIdx.x; t0 < MT * 14; t0 += gridDim.x) {
    const int t = xcd_tile(t0, MT * 14);
    const int mt = t / 14, nt = t % 14;
    const int m0 = mt * 128;
    const bool isq = nt < 6;
    const int n0 = (isq ? nt : nt - 6) * 128;
    f32x16 acc[2][2];
    gemm_tile(smem, isq ? 6 : 4, Z + (isq ? C_CQ : C_CKV), ZLD, m0, wl + (isq ? WO_UQ : WO_UKV), isq ? 384 : 256, n0, acc);
    unsigned short* dst = isq ? QB : KV;
    const int ldd = isq ? 768 : 1024;
    unsigned short* Cs = (unsigned short*)smem;
    epi_foreach(acc, [&](int row, int col, float v) __attribute__((always_inline)) { Cs[row * 136 + col] = f2bf(v); });
    __syncthreads();
    store_tile16(Cs, dst + (size_t)m0 * ldd + n0, ldd);
    __syncthreads();
  }
}

DI void phase_token_c(const Params& P, int layer, char* smem) {
  const unsigned short* Z = (const unsigned short*)(P.ws + OFF_Z);
  unsigned short* QB = (unsigned short*)(P.ws + OFF_QB);
  unsigned short* KB = (unsigned short*)(P.ws + OFF_KB);
  const unsigned short* KV = (const unsigned short*)(P.ws + OFF_HN);
  const int lane = ltid() & 63, w = ltid() >> 6;
  float* rowbuf = (float*)smem + w * 800;
  const float* gq = P.b_q_norm + layer * 96;
  const float* gk = P.b_k_norm + layer * 96;
  const int ngroups = T_ / 4;
  for (int gi = blockIdx.x; gi < ngroups; gi += gridDim.x) {
    const int t = gi * 4 + w;
    unsigned short* qr = QB + (size_t)t * 768;
#pragma unroll
    for (int i = 0; i < 3; ++i) {
      const u32x2 u = *(const u32x2*)(qr + (lane + 64 * i) * 4);
      float4 f = {bflo(u.x), bfhi(u.x), bflo(u.y), bfhi(u.y)};
      *(float4*)(rowbuf + (lane + 64 * i) * 4) = f;
    }
    if (lane < 16) {
      const float inv = powf(10000.f, -(float)lane / 16.f);
      const float ang = (float)(t % S_) * inv;
      float sn, cs;
      sincosf(ang, &sn, &cs);
      rowbuf[768 + lane] = cs; rowbuf[784 + lane] = sn;
    }
    __syncthreads();
    {
      float f[12];
      float ss = 0.f;
      const int hd = lane >> 3, j0 = (lane & 7) * 12;
#pragma unroll
      for (int e = 0; e < 12; ++e) {
        const int j = j0 + e;
        float v;
        if (j < 64) v = rowbuf[hd * 96 + j];
        else {
          const int i = (j - 64) & 15;
          const float x1 = rowbuf[hd * 96 + 64 + i], x2 = rowbuf[hd * 96 + 80 + i];
          const float cs = rowbuf[768 + i], sn = rowbuf[784 + i];
          v = (j < 80) ? (x1 * cs - x2 * sn) : (x1 * sn + x2 * cs);
        }
        f[e] = v; ss += v * v;
      }
      ss += __shfl_xor(ss, 1); ss += __shfl_xor(ss, 2); ss += __shfl_xor(ss, 4);
      const float r = rsqrtf(ss * (1.f / 96) + EPS);
      unsigned o[6];
#pragma unroll
      for (int e = 0; e < 6; ++e) o[e] = pk2(f[2 * e] * r * gq[j0 + 2 * e], f[2 * e + 1] * r * gq[j0 + 2 * e + 1]);
      u32x2* op = (u32x2*)(qr + lane * 12);
      op[0] = u32x2{o[0], o[1]}; op[1] = u32x2{o[2], o[3]}; op[2] = u32x2{o[4], o[5]};
    }
    {
      float f[12];
      float ss = 0.f;
      const int hd = lane >> 3, j0 = (lane & 7) * 12;
#pragma unroll
      for (int e = 0; e < 12; ++e) {
        const int j = j0 + e;
        const float v = (j < 64) ? bf2f(KV[(size_t)t * 1024 + hd * 128 + j]) : bf2f(Z[(size_t)t * ZLD + C_KR + (j - 64)]);
        f[e] = v; ss += v * v;
      }
      ss += __shfl_xor(ss, 1); ss += __shfl_xor(ss, 2); ss += __shfl_xor(ss, 4);
      const float r = rsqrtf(ss * (1.f / 96) + EPS);
      unsigned o[6];
#pragma unroll
      for (int e = 0; e < 6; ++e) o[e] = pk2(f[2 * e] * r * gk[j0 + 2 * e], f[2 * e + 1] * r * gk[j0 + 2 * e + 1]);
      u32x2* op = (u32x2*)(KB + ((size_t)((t / S_) * 8 + hd) * S_ + (t % S_)) * 96 + j0);
      op[0] = u32x2{o[0], o[1]}; op[1] = u32x2{o[2], o[3]}; op[2] = u32x2{o[4], o[5]};
    }
    __syncthreads();
  }
  __syncthreads();
  transpose_v(KV, 1024, 64, 128, (unsigned short*)(P.ws + OFF_VTB), smem);
}

DI unsigned f2o(float f) { unsigned u = __float_as_uint(f); return u ^ ((u >> 31) ? 0xffffffffu : 0x80000000u); }
DI float o2f(unsigned u) { return __uint_as_float(u ^ ((u >> 31) ? 0x80000000u : 0xffffffffu)); }

DI void topk_compact(float* sc, unsigned short* ix, int* cntp, float* taup, int lane) {
  const int n = *cntp;
  unsigned u[8]; unsigned id[8]; bool valid[8];
#pragma unroll
  for (int i = 0; i < 8; ++i) {
    const int p = lane + 64 * i;
    valid[i] = p < n;
    u[i] = valid[i] ? f2o(sc[p]) : 0u;
    id[i] = valid[i] ? (unsigned)ix[p] : 0xffffu;
  }
  unsigned prefix = 0; int kk = 256;
  for (int bit = 31; bit >= 0; --bit) {
    const unsigned cand = (prefix >> bit) | 1u;
    int c = 0;
#pragma unroll
    for (int i = 0; i < 8; ++i) c += __popcll(__ballot(valid[i] && ((u[i] >> bit) == cand)));
    if (c >= kk) prefix |= (1u << bit); else kk -= c;
  }
  int ceq = 0;
#pragma unroll
  for (int i = 0; i < 8; ++i) ceq += __popcll(__ballot(valid[i] && u[i] == prefix));
  unsigned idthr = 0xffffu;
  if (ceq != kk) {
    unsigned p2 = 0; int k2 = kk;
    for (int bit = 13; bit >= 0; --bit) {
      int c0 = 0;
#pragma unroll
      for (int i = 0; i < 8; ++i) c0 += __popcll(__ballot(valid[i] && u[i] == prefix && ((id[i] >> bit) == (p2 >> bit))));
      if (c0 < k2) { k2 -= c0; p2 |= (1u << bit); }
    }
    idthr = p2;
  }
  int base = 0;
  const unsigned long long lt = (1ull << lane) - 1ull;
#pragma unroll
  for (int i = 0; i < 8; ++i) {
    const bool keep = valid[i] && (u[i] > prefix || (u[i] == prefix && id[i] <= idthr));
    const unsigned long long m = __ballot(keep);
    if (keep) {
      const int pos = base + __popcll(m & lt);
      sc[pos] = o2f(u[i]); ix[pos] = (unsigned short)id[i];
    }
    base += __popcll(m);
  }
  if (lane == 0) { *cntp = base; *taup = o2f(prefix); }
}

constexpr int HB_LO = 124 * 16, HB_P = 192, HB_WORDS = 387;

template <int MODE>
DI void indexer_pass(const _Float16* kbase, int ntile_in, int ts, const f16x8 (&qf)[8][2], const f16x8 (&qc)[2], const float (&wq)[8], float* csc,
                     unsigned short* cix, int* cnt, float* tau, unsigned* hist, int* oflow, int lane, int w) {
  constexpr int NG = (MODE == 2) ? 2 : 4;
  const int ntile = (ntile_in + ts - 1) / ts;
  const int q = lane & 15, kg = lane >> 4;
  const int nstep = (ntile + NG - 1) / NG;
  f16x8 cur[NG][2], nxt[NG][2];
#pragma unroll
  for (int g = 0; g < NG; ++g) {
    int tl = g; tl = tl < ntile ? tl : ntile - 1;
    cur[g][0] = *(const f16x8*)(kbase + (size_t)(tl * ts) * 64 * ZLD);
    cur[g][1] = *(const f16x8*)(kbase + (size_t)(tl * ts) * 64 * ZLD + 32);
  }
  float tq = (MODE == 0) ? 0.f : tau[q];
  for (int st = 0; st < nstep; ++st) {
#pragma unroll
    for (int g = 0; g < NG; ++g) {
      int tl = NG * (st + 1) + g; tl = tl < ntile ? tl : ntile - 1;
      nxt[g][0] = *(const f16x8*)(kbase + (size_t)(tl * ts) * 64 * ZLD);
      nxt[g][1] = *(const f16x8*)(kbase + (size_t)(tl * ts) * 64 * ZLD + 32);
    }
    if (MODE == 2) tq = tau[q];
#pragma unroll
    for (int g = 0; g < NG; ++g) {
      const int tl = NG * st + g;
      if (tl < ntile) {
        f32x4 lin = {0.f, 0.f, 0.f, 0.f};
        lin = __builtin_amdgcn_mfma_f32_16x16x32_f16(cur[g][0], qc[0], lin, 0, 0, 0);
        lin = __builtin_amdgcn_mfma_f32_16x16x32_f16(cur[g][1], qc[1], lin, 0, 0, 0);
        float s[4] = {lin[0], lin[1], lin[2], lin[3]};
        f32x4 accp = {0.f, 0.f, 0.f, 0.f};
        accp = __builtin_amdgcn_mfma_f32_16x16x32_f16(cur[g][0], qf[0][0], accp, 0, 0, 0);
        accp = __builtin_amdgcn_mfma_f32_16x16x32_f16(cur[g][1], qf[0][1], accp, 0, 0, 0);
#pragma unroll
        for (int h = 0; h < 8; ++h) {
          f32x4 accn = {0.f, 0.f, 0.f, 0.f};
          if (h < 7) {
            accn = __builtin_amdgcn_mfma_f32_16x16x32_f16(cur[g][0], qf[h + 1][0], accn, 0, 0, 0);
            accn = __builtin_amdgcn_mfma_f32_16x16x32_f16(cur[g][1], qf[h + 1][1], accn, 0, 0, 0);
          }
          __builtin_amdgcn_sched_barrier(0);
#pragma unroll
          for (int r = 0; r < 4; ++r) {
            s[r] = fmaf(wq[h], __builtin_fabsf(accp[r]), s[r]);
            asm("" : "+v"(s[r]));
          }
          __builtin_amdgcn_sched_barrier(0);
          accp = accn;
        }
        if (MODE == 0) {
#pragma unroll
          for (int r = 0; r < 4; ++r) {
            const float score = s[r] + 0.f;
            const unsigned bits = __float_as_uint(score);
            int p = (int)((bits & 0x7fffffffu) >> 19) - (HB_LO - 1);
            p = p < 0 ? 0 : (p > HB_P ? HB_P : p);
            const int bin = (bits >> 31) ? (HB_P - p) : (HB_P + 1 + p);
            atomicAdd(hist + q * HB_WORDS + bin, 1u);
          }
        } else {
          float sc4[4]; bool ps[4]; int np = 0;
#pragma unroll
          for (int r = 0; r < 4; ++r) { sc4[r] = s[r] + 0.f; ps[r] = sc4[r] > tq; np += ps[r] ? 1 : 0; }
          if (__ballot(np > 0)) {
            int pos = q * 512 + atomicAdd(&cnt[q], np);
            const int lim = q * 512 + 512;
            if (MODE != 2) { if (__ballot(pos + np > lim)) { if (pos + np > lim) *oflow = 1; } }
            const int dummy = 16 * 512 + lane;
            const unsigned kbase16 = (unsigned)(tl * 64 + w * 16 + kg * 4);
#pragma unroll
            for (int r = 0; r < 4; ++r) {
              const bool ok = ps[r] && (MODE == 2 || pos < lim);
              const int idx = ok ? pos : dummy;
              csc[idx] = sc4[r];
              cix[idx] = (unsigned short)(kbase16 + r);
              pos += ps[r] ? 1 : 0;
            }
          }
        }
      }
    }
    if (MODE == 2) {
      __syncthreads();
#pragma unroll 1
      for (int jj = 0; jj < 4; ++jj) {
        const int qq = w * 4 + jj;
        if (cnt[qq] > 384) topk_compact(csc + qq * 512, cix + qq * 512, cnt + qq, tau + qq, lane);
      }
      __syncthreads();
    }
#pragma unroll
    for (int g = 0; g < NG; ++g) { cur[g][0] = nxt[g][0]; cur[g][1] = nxt[g][1]; }
  }
}

DI void phase_indexer(const Params& P, char* smem) {
  float* csc = (float*)(smem);
  unsigned short* cix = (unsigned short*)(smem + 34816);
  unsigned* hist = (unsigned*)(smem);
  int* cnt = (int*)(smem + 52224);
  float* tau = (float*)(cnt + 16);
  int* oflow = cnt + 32;
  const int tid = ltid(), lane = tid & 63, w = tid >> 6;
  const _Float16* Zh = (const _Float16*)(P.ws + OFF_Z);
  unsigned* mask = (unsigned*)(P.ws + OFF_MASK);
  const int NT = T_ / 16, G = gridDim.x, j = blockIdx.x;
  for (int k = 0; k * G < NT; ++k) {
    const int rk = k * G + ((k & 1) ? (G - 1 - j) : j);
    if (rk >= NT) continue;
    const int c = 255 - (rk >> 3), sub = (k & 1) ? 7 - (rk & 7) : (rk & 7);
    const int b = sub >> 2, qsub = sub & 3;
    const int t0 = b * S_ + c * 64 + qsub * 16;
    if (c < 4) {
      if (tid < 2 * (c + 1) * 16) {
        const int kb = tid >> 4, ql = qsub * 16 + (tid & 15);
        mask[mask_base(b, c) + kb * 64 + ql] = 0xffffffffu;
      }
      continue;
    }
    const int q = lane & 15, kg = lane >> 4;
    f16x8 qf[8][2];
#pragma unroll
    for (int h = 0; h < 8; ++h)
#pragma unroll
      for (int ks = 0; ks < 2; ++ks)
        qf[h][ks] = *(const f16x8*)(Zh + (size_t)(t0 + q) * ZLD + C_QI + h * 64 + ks * 32 + kg * 8);
    float wq[8];
    {
      const f16x8 wv = *(const f16x8*)(Zh + (size_t)(t0 + q) * ZLD + C_WI);
#pragma unroll
      for (int h = 0; h < 8; ++h) wq[h] = (float)wv[h];
    }
    f16x8 qc[2];
#pragma unroll
    for (int ks = 0; ks < 2; ++ks)
#pragma unroll
      for (int jx = 0; jx < 8; ++jx) {
        float a = 0.f;
#pragma unroll
        for (int h = 0; h < 8; ++h) a = fmaf(wq[h], (float)qf[h][ks][jx], a);
        qc[ks][jx] = (_Float16)a;
      }
    const _Float16* kbase = Zh + (size_t)(b * S_ + w * 16 + q) * ZLD + C_KI + kg * 8;
    const int ntile = c + 1;
    for (int attempt = (ntile > 16) ? 0 : 1;; ++attempt) {
      __syncthreads();
      for (int i = tid; i < 16 * HB_WORDS; i += 256) hist[i] = 0u;
      if (tid < 16) { cnt[tid] = 0; tau[tid] = -INFINITY; }
      if (tid == 0) *oflow = 0;
      __syncthreads();
      if (attempt >= 2) {
        indexer_pass<2>(kbase, ntile, 1, qf, qc, wq, csc, cix, cnt, tau, hist, oflow, lane, w);
        break;
      }
      const int ts = attempt == 0 ? 2 : 1;
      indexer_pass<0>(kbase, ntile, ts, qf, qc, wq, csc, cix, cnt, tau, hist, oflow, lane, w);
      __syncthreads();
      if (tid < 16) {
        const int nsamp = (ntile + ts - 1) / ts;
        const int target = attempt == 0 ? (320 * nsamp + ntile - 1) / ntile : 256;
        const unsigned* hq = hist + tid * HB_WORDS;
        int cum = 0, B = 0;
        for (int bin = 2 * HB_P + 1; bin >= 0; --bin) {
          cum += (int)hq[bin];
          if (cum >= target) { B = bin; break; }
        }
        float t;
        if (B > HB_P) {
          const int p = B - HB_P - 1;
          t = (p == 0) ? -1e-30f : __uint_as_float((((unsigned)(p + HB_LO - 1)) << 19) - 1u);
        } else {
          const int p = HB_P - B;
          t = (p == HB_P) ? -INFINITY : -__uint_as_float(((unsigned)(p + HB_LO)) << 19);
        }
        tau[tid] = t;
      }
      __syncthreads();
      indexer_pass<1>(kbase, ntile, 1, qf, qc, wq, csc, cix, cnt, tau, hist, oflow, lane, w);
      __syncthreads();
      if (tid < 16 && cnt[tid] < 256) *oflow = 1;
      __syncthreads();
      if (!*oflow) break;
    }
#pragma unroll 1
    for (int jj = 0; jj < 4; ++jj) {
      const int qq = w * 4 + jj;
      if (cnt[qq] > 256) topk_compact(csc + qq * 512, cix + qq * 512, cnt + qq, tau + qq, lane);
      unsigned* mrow = mask + mask_base(b, c) + (qsub * 16 + qq);
#pragma unroll
      for (int i = 0; i < 4; ++i) {
        const unsigned key = cix[qq * 512 + lane + 64 * i];
        atomicOr(mrow + (key >> 5) * 64, 1u << (key & 31));
      }
    }
    __syncthreads();
  }
}

DI int t5_bucket(int rel) {
  const int n = rel < 0 ? -rel : rel;
  int bkt;
  if (n < 8) bkt = n; else if (n < 12) bkt = 8; else if (n < 16) bkt = 9; else if (n < 23) bkt = 10; else if (n < 32) bkt = 11;
  else if (n < 46) bkt = 12; else if (n < 64) bkt = 13; else if (n < 91) bkt = 14; else bkt = 15;
  return bkt + (rel > 0 ? 16 : 0);
}

template <int DQK, bool MIXA, bool PIPE>
DI void attn_item(const Params& P, int layer, char* smem, int b, int h, int qt) {
  constexpr int NS = DQK / 16;
  constexpr int KCH = DQK / 8;
  constexpr int KROWB = DQK * 2;
  constexpr int KTILE_B = 64 * KROWB;
  constexpr int STG_B = 20480;
  constexpr int NKI = KTILE_B / 4096;
  float* biasT = (float*)(smem + 2 * STG_B);
  const int tid = ltid(), lane = tid & 63, w = tid >> 6;
  const int H = lane >> 5, l31 = lane & 31;
  const unsigned short* Z = (const unsigned short*)(P.ws + OFF_Z);
  const unsigned short *Qp, *Kp, *VT;
  int ldq, ldk;
  unsigned short* Yp = (unsigned short*)(P.ws + OFF_Z);
  if (MIXA) {
    Qp = Z + C_QA + h * 64; Kp = Z + C_KA + h * 64 + (size_t)b * S_ * ZLD; ldq = ZLD; ldk = ZLD;
    VT = (const unsigned short*)(P.ws + OFF_VTA) + (size_t)((b * 8 + h) * 64) * S_;
    Yp += C_VA + h * 64;
  } else {
    Qp = (const unsigned short*)(P.ws + OFF_QB) + h * 96; ldq = 768;
    Kp = (const unsigned short*)(P.ws + OFF_KB) + (size_t)(b * 8 + h) * S_ * 96; ldk = 96;
    VT = (const unsigned short*)(P.ws + OFF_VTB) + (size_t)((b * 8 + h) * 64) * S_;
    Yp += C_QI + h * 64;
  }
  const unsigned* mask = (const unsigned*)(P.ws + OFF_MASK);
  const int tq0 = qt * 128 + w * 32;
  const int qpos = tq0 + l31;
  const int cw = tq0 >> 6;
  const size_t tokq = (size_t)b * S_ + qpos;
  const float sl2 = (MIXA ? 0.125f : 0.10206207261596575f) * LOG2E;
  float mfix;
  {
    const float* g1 = MIXA ? (P.a_q_norm + layer * 64) : (P.b_q_norm + layer * 96);
    const float* g2 = MIXA ? (P.a_k_norm + layer * 64) : (P.b_k_norm + layer * 96);
    float a1 = 0.f, a2 = 0.f;
    for (int i = 0; i < DQK; ++i) { a1 = fmaxf(a1, fabsf(g1[i])); a2 = fmaxf(a2, fabsf(g2[i])); }
    mfix = (float)DQK * 1.02f * a1 * a2 * sl2;
    if (MIXA) {
      const float b15 = P.rel_bias[15 * 8 + h];
      float bm = 0.f;
      for (int i = 0; i < 32; ++i) bm = fmaxf(bm, P.rel_bias[i * 8 + h] - b15);
      mfix += bm * LOG2E;
    }
  }
  if (MIXA) {
    const int rel = tid - 192;
    const float b15 = P.rel_bias[15 * 8 + h];
    biasT[tid] = (P.rel_bias[t5_bucket(rel) * 8 + h] - b15) * LOG2E;
  }
  bf16x8 qf[NS];
#pragma unroll
  for (int s = 0; s < NS; ++s) qf[s] = *(const bf16x8*)(Qp + tokq * ldq + 16 * s + 8 * H);
  const int nkt = 2 * qt + 2;
  unsigned koff[NKI], voff[2];
#pragma unroll
  for (int i = 0; i < NKI; ++i) {
    const int e = (w * NKI + i) * 64 + lane;
    const int row = e / KCH, slot = e % KCH;
    const int c = slot ^ (MIXA ? ((row >> 1) & 7) : ((row >> 2) & 3));
    koff[i] = (unsigned)((row * ldk + c * 8) * 2);
  }
#pragma unroll
  for (int i = 0; i < 2; ++i) {
    const int e = (w * 2 + i) * 64 + lane;
    const int row = e >> 3, slot = e & 7;
    const int c = slot ^ ((row >> 1) & 7);
    voff[i] = (unsigned)((row * S_ + c * 8) * 2);
  }
  unsigned mwn[2] = {0u, 0u};
  auto issue_loads = [&](int kt) __attribute__((always_inline)) {
    const char* kbp = (const char*)(Kp + (size_t)(kt * 64) * ldk);
    const char* vbp = (const char*)(VT + kt * 64);
    char* sk = smem + (kt & 1) * STG_B;
#pragma unroll
    for (int i = 0; i < NKI; ++i)
      __builtin_amdgcn_global_load_lds((const unsigned*)(kbp + koff[i]), (unsigned*)(sk + (w * NKI + i) * 1024), 16, 0, 0);
#pragma unroll
    for (int i = 0; i < 2; ++i)
      __builtin_amdgcn_global_load_lds((const unsigned*)(vbp + voff[i]), (unsigned*)(sk + KTILE_B + (w * 2 + i) * 1024), 16, 0, 0);
    if (MIXA) {
      if (kt <= cw) {
        const unsigned* mp = mask + mask_base(b, cw) + (2 * kt) * 64 + (qpos & 63);
        mwn[0] = mp[0]; mwn[1] = mp[64];
      }
    }
  };
  issue_loads(0);
  f32x16 o[2];
#pragma unroll
  for (int d = 0; d < 2; ++d)
#pragma unroll
    for (int i = 0; i < 16; ++i) o[d][i] = 0.f;
  float l = 0.f;
  const int pr = (l31 & ~12) | ((l31 & 4) << 1) | ((l31 & 8) >> 1);
  const int swk = MIXA ? ((pr >> 1) & 7) : ((pr >> 2) & 3), swv = (l31 >> 1) & 7;
  asm volatile("s_waitcnt vmcnt(0)" ::: "memory");
  __syncthreads();
  for (int kt = 0; kt < nkt; ++kt) {
    unsigned mw[2] = {mwn[0], mwn[1]};
    if (kt + 1 < nkt) issue_loads(kt + 1);
    const char* Ks = smem + (kt & 1) * STG_B;
    const char* Vs = Ks + KTILE_B;
    if (kt <= cw) {
      const int kc = kt;
      bf16x8 kf[2][NS];
#pragma unroll
      for (int kb = 0; kb < 2; ++kb)
#pragma unroll
        for (int s = 0; s < NS; ++s) kf[kb][s] = *(const bf16x8*)(Ks + (32 * kb + pr) * KROWB + (((2 * s + H) ^ swk) << 4));
      __builtin_amdgcn_sched_barrier(0);
      f32x16 sacc[2];
#pragma unroll
      for (int kb = 0; kb < 2; ++kb)
#pragma unroll
        for (int i = 0; i < 16; ++i) sacc[kb][i] = 0.f;
#pragma unroll
      for (int s = 0; s < NS; ++s) sacc[0] = __builtin_amdgcn_mfma_f32_32x32x16_bf16(kf[0][s], qf[s], sacc[0], 0, 0, 0);
      bf16x8 vf[2][2][2];
#pragma unroll
      for (int d = 0; d < 2; ++d)
#pragma unroll
        for (int kb = 0; kb < 2; ++kb)
#pragma unroll
          for (int s2 = 0; s2 < 2; ++s2)
            vf[d][kb][s2] = *(const bf16x8*)(Vs + (d * 32 + l31) * 128 + (((4 * kb + 2 * s2 + H) ^ swv) << 4));
      __builtin_amdgcn_sched_barrier(0);
      const bool near = MIXA && (kc >= cw - 2);
      f32x2 ls2 = {0.f, 0.f};
      const f32x2 sl2v = {sl2, sl2}, mfixv = {mfix, mfix};
      unsigned pkw[2][2][4];
      unsigned mrot[2];
#pragma unroll
      for (int kb = 0; kb < 2; ++kb) mrot[kb] = MIXA ? ((mw[kb] >> (8 * H)) << 8) : 0u;
      auto chunk = [&](int kb, int c) __attribute__((always_inline)) {
        const int s2 = 1 - (c >> 2), e = 3 - (c & 3);
        const int r0 = 8 * s2 + 2 * e;
        if (MIXA && c == 4) mrot[kb] <<= 8;
        f32x2 xv2 = {sacc[kb][r0], sacc[kb][r0 + 1]};
        xv2 = xv2 * sl2v - mfixv;
        if (MIXA) {
          if (near) {
            const int kl = 16 * (r0 >> 3) + 8 * H + (r0 & 7);
            const int rel = kc * 64 + 32 * kb + kl - qpos;
            xv2.x += biasT[rel + 192];
            xv2.y += biasT[rel + 193];
          }
        }
        f32x2 p2 = {__builtin_amdgcn_exp2f(xv2.x), __builtin_amdgcn_exp2f(xv2.y)};
        if (MIXA) {
          float px = p2.x, py = p2.y;
          asm volatile("v_add_co_u32 %0, vcc, %0, %0\n\tv_cndmask_b32 %1, 0, %1, vcc" : "+v"(mrot[kb]), "+v"(py) : : "vcc");
          asm volatile("v_add_co_u32 %0, vcc, %0, %0\n\tv_cndmask_b32 %1, 0, %1, vcc" : "+v"(mrot[kb]), "+v"(px) : : "vcc");
          p2.x = px; p2.y = py;
        }
        ls2 += p2;
        pkw[kb][s2][e] = pk2(p2.x, p2.y);
      };
      {
        int c0 = 0;
#pragma unroll
        for (int s = 0; s < NS; ++s) {
          sacc[1] = __builtin_amdgcn_mfma_f32_32x32x16_bf16(kf[1][s], qf[s], sacc[1], 0, 0, 0);
          const int cend = (8 * (s + 1)) / NS;
#pragma unroll
          for (int c = 0; c < 8; ++c) if (c >= c0 && c < cend) chunk(0, c);
          c0 = cend;
          __builtin_amdgcn_sched_barrier(0);
        }
      }
      bf16x8 pf0[2], pf1[2];
#pragma unroll
      for (int s2 = 0; s2 < 2; ++s2) { u32x4 t = {pkw[0][s2][0], pkw[0][s2][1], pkw[0][s2][2], pkw[0][s2][3]}; pf0[s2] = __builtin_bit_cast(bf16x8, t); }
#pragma unroll
      for (int j = 0; j < 4; ++j) {
        const int s2 = j >> 1, d = j & 1;
        o[d] = __builtin_amdgcn_mfma_f32_32x32x16_bf16(vf[d][0][s2], pf0[s2], o[d], 0, 0, 0);
        chunk(1, 2 * j); chunk(1, 2 * j + 1);
        __builtin_amdgcn_sched_barrier(0);
      }
#pragma unroll
      for (int s2 = 0; s2 < 2; ++s2) { u32x4 t = {pkw[1][s2][0], pkw[1][s2][1], pkw[1][s2][2], pkw[1][s2][3]}; pf1[s2] = __builtin_bit_cast(bf16x8, t); }
#pragma unroll
      for (int j = 0; j < 4; ++j) {
        const int s2 = j >> 1, d = j & 1;
        o[d] = __builtin_amdgcn_mfma_f32_32x32x16_bf16(vf[d][1][s2], pf1[s2], o[d], 0, 0, 0);
      }
      l += ls2.x + ls2.y;
    }
    asm volatile("s_waitcnt vmcnt(0)" ::: "memory");
    __syncthreads();
  }
  const float lt = l + __shfl_xor(l, 32);
  const float inv = 1.f / lt;
  unsigned short* yr = Yp + tokq * ZLD;
#pragma unroll
  for (int d = 0; d < 2; ++d)
#pragma unroll
    for (int g = 0; g < 4; ++g) {
      u32x2 ov;
      ov.x = pk2(o[d][4 * g] * inv, o[d][4 * g + 1] * inv);
      ov.y = pk2(o[d][4 * g + 2] * inv, o[d][4 * g + 3] * inv);
      *(u32x2*)(yr + d * 32 + 8 * g + 4 * H) = ov;
    }
}

#ifndef PIPE_MLA
#define PIPE_MLA false
#endif
#ifndef PIPE_MIXA
#define PIPE_MIXA false
#endif
DI void phase_attention(const Params& P, int layer, char* smem, unsigned xcc) {
  unsigned* ctr = (unsigned*)(P.ws + OFF_CTR) + layer * 8 * 16;
  volatile int* slot = (volatile int*)(smem + 65528);
  const int tid = ltid();
  for (int d = 0; d < 8; ++d) {
    const int h = (int)((xcc + d) & 7u);
    for (;;) {
      if (tid == 0) *slot = (int)atomicAdd(ctr + h * 16, 1u);
      __syncthreads();
      const int r = *slot;
      __syncthreads();
      if (r >= 512) break;
      const int qt = 127 - (r & 127);
      const int mixer = (r >> 8) & 1, b = (r >> 7) & 1;
      if (mixer) attn_item<96, false, PIPE_MLA>(P, layer, smem, b, h, qt);
      else attn_item<64, true, PIPE_MIXA>(P, layer, smem, b, h, qt);
    }
  }
}

DI float sigmoidf_(float v) { return __builtin_amdgcn_rcpf(1.f + __expf(-v)); }

DI void phase_merge(const Params& P, int layer, char* smem) {
  const bf16* hn = (const bf16*)(P.ws + OFF_HN);
  const bf16* Z = (const bf16*)(P.ws + OFF_Z);
  const bf16* wl = (const bf16*)(P.ws + OFF_WT) + layer * W_LAYER;
  unsigned short* MG = (unsigned short*)(P.ws + OFF_QB);
  unsigned short* TG = (unsigned short*)(P.ws + OFF_VTA);
  const float* bg = P.b_gate + layer * 2048;
  for (int t0 = blockIdx.x; t0 < 256 * 8; t0 += gridDim.x) {
    const int t = xcd_tile(t0, 256 * 8);
    const int m0 = (t >> 3) * 128, n0 = (t & 7) * 128;
#pragma unroll 1
    for (int step = 0; step < 4; ++step) {
      f32x16 acc[2][2];
      const bool gate = !(step & 1);
      const bf16* A = gate ? hn : (Z + (step == 1 ? C_VA : C_QI));
      const bf16* Bt = wl + (step == 0 ? WO_IN + (size_t)C_GA * 1024 : step == 1 ? WO_PA : step == 2 ? WO_IN + (size_t)C_GB * 1024 : WO_PB);
      gemm_tile(smem, gate ? 16 : 8, A, gate ? 1024 : ZLD, m0, Bt, gate ? 1024 : 512, n0, acc);
      if (gate) {
        unsigned short* dst = step == 0 ? MG : TG;
        const float* bgs = bg + (step == 0 ? 0 : 1024);
        unsigned short* Cs = (unsigned short*)smem;
        epi_foreach(acc, [&](int row, int col, float v) __attribute__((always_inline)) {
          Cs[row * 136 + col] = f2bf(sigmoidf_(v + bgs[n0 + col]));
        });
        __syncthreads();
        store_tile16(Cs, dst + (size_t)m0 * 1024 + n0, 1024);
        __syncthreads();
      } else {
        unsigned short* Cs = (unsigned short*)smem;
        epi_foreach(acc, [&](int row, int col, float v) __attribute__((always_inline)) { Cs[row * 136 + col] = f2bf(v); });
        __syncthreads();
        const int tid_ = ltid();
#pragma unroll 2
        for (int i = 0; i < 8; ++i) {
          const int idx = tid_ + 256 * i;
          const int row = idx >> 4, c8 = (idx & 15) * 8;
          u32x4* gp = (u32x4*)(MG + (size_t)(m0 + row) * 1024 + n0 + c8);
          const u32x4 mg = *gp;
          const u32x4 pj = *(const u32x4*)(Cs + row * 136 + c8);
          u32x4 ov;
          if (step == 1) {
#pragma unroll
            for (int e = 0; e < 4; ++e) ov[e] = pk2(bflo(mg[e]) * bflo(pj[e]), bfhi(mg[e]) * bfhi(pj[e]));
          } else {
            const u32x4 tg = *(const u32x4*)(TG + (size_t)(m0 + row) * 1024 + n0 + c8);
#pragma unroll
            for (int e = 0; e < 4; ++e) ov[e] = pk2(bflo(mg[e]) + bflo(tg[e]) * bflo(pj[e]), bfhi(mg[e]) + bfhi(tg[e]) * bfhi(pj[e]));
          }
          *gp = ov;
        }
        __syncthreads();
      }
    }
  }
}

DI void phase_out(const Params& P, int layer, const float* xin, char* smem) {
  const bf16* MG = (const bf16*)(P.ws + OFF_QB);
  const bf16* wl = (const bf16*)(P.ws + OFF_WT) + layer * W_LAYER;
  const int lane = ltid() & 63, w = ltid() >> 6;
  const int wm = w >> 1, wn = w & 1;
  for (int t0 = blockIdx.x; t0 < 256 * 8; t0 += gridDim.x) {
    const int t = xcd_tile(t0, 256 * 8);
    const int m0 = (t >> 3) * 128, n0 = (t & 7) * 128;
    f32x16 acc[2][2];
    float xr[2][2][16];
    const unsigned obase_b = 4u * (unsigned)((m0 + wm * 64 + 4 * (lane >> 5)) * 1024 + n0 + wn * 64 + (lane & 31));
#pragma unroll
    for (int mb = 0; mb < 2; ++mb)
#pragma unroll
      for (int nb = 0; nb < 2; ++nb)
#pragma unroll
        for (int r = 0; r < 16; ++r) xr[mb][nb][r] = (*uoff(xin + ((mb * 32 + (r & 3) + 8 * (r >> 2)) * 1024 + nb * 32), obase_b));
    gemm_tile(smem, 16, MG, 1024, m0, wl + WO_OUT, 1024, n0, acc);
#pragma unroll
    for (int mb = 0; mb < 2; ++mb)
#pragma unroll
      for (int nb = 0; nb < 2; ++nb)
#pragma unroll
        for (int r = 0; r < 16; ++r)
          (*uoff(P.out + ((mb * 32 + (r & 3) + 8 * (r >> 2)) * 1024 + nb * 32), obase_b)) = xr[mb][nb][r] + acc[mb][nb][r];
  }
}

DI void phase_up(const Params& P, int layer, char* smem) {
  const bf16* hn = (const bf16*)(P.ws + OFF_HN);
  const bf16* wup = (const bf16*)(P.ws + OFF_WT) + layer * W_LAYER + WO_UP;
  unsigned short* ACT = (unsigned short*)(P.ws + OFF_Z);
  const float* cw = P.conv_w + (size_t)layer * 3 * 5632;
  const float* cb = P.conv_b + (size_t)layer * 5632;
  unsigned short* Cs = (unsigned short*)smem;
  const int tid = ltid();
  constexpr int MT = 262, NT = 44;
  for (int t0 = blockIdx.x; t0 < MT * NT; t0 += gridDim.x) {
    const int tl = xcd_tile(t0, MT * NT) - (t0 & 7) * ((MT * NT) >> 3);
    const int mt = (t0 & 1) * 131 + tl / 11, nt = ((t0 & 7) >> 1) * 11 + tl % 11;
    const int b = mt / 131, i = mt % 131;
    const int tb0 = i * 126 - 2;
    unsigned aoff[4], boff[4];
    const char* Abase = (const char*)(hn + (size_t)b * S_ * 1024);
    const unsigned zoff = (unsigned)((P.ws + OFF_ZPAGE) - Abase);
#pragma unroll
    for (int q = 0; q < 4; ++q) {
      const int r = glds_row(q), ch = glds_chunk(r);
      const int tb = tb0 + r;
      const bool ok = (tb >= 0) && (tb < S_);
      aoff[q] = ok ? (unsigned)((tb * 1024 + ch * 8) * 2) : zoff;
      const int wr = (r < 64) ? (nt * 64 + r) : (DFF + nt * 64 + r - 64);
      boff[q] = (unsigned)((wr * 1024 + ch * 8) * 2);
    }
    f32x16 acc[2][2];
    gemm_core(smem, 16, Abase, (const char*)wup, aoff, boff, acc);
    epi_foreach(acc, [&](int row, int col, float v) __attribute__((always_inline)) { Cs[row * 136 + col] = f2bf(v); });
    __syncthreads();
    {
      const int col = tid & 63, rb = tid >> 6;
      const int cv = nt * 64 + col, cg_ = DFF + nt * 64 + col;
      const float w0v = cw[cv], w1v = cw[5632 + cv], w2v = cw[2 * 5632 + cv], bv = cb[cv];
      const float w0g = cw[cg_], w1g = cw[5632 + cg_], w2g = cw[2 * 5632 + cg_], bgt = cb[cg_];
      for (int r = 2 + rb; r < 128; r += 4) {
        const int tb = tb0 + r;
        if (tb < S_) {
          const float val = bv + w0v * bf2f(Cs[(r - 2) * 136 + col]) + w1v * bf2f(Cs[(r - 1) * 136 + col]) + w2v * bf2f(Cs[r * 136 + col]);
          const float gat = bgt + w0g * bf2f(Cs[(r - 2) * 136 + 64 + col]) + w1g * bf2f(Cs[(r - 1) * 136 + 64 + col]) + w2g * bf2f(Cs[r * 136 + 64 + col]);
          const float a = gat / (1.f + __expf(-gat)) * val;
          ACT[(size_t)(b * S_ + tb) * DFF + cv] = f2bf(a);
        }
      }
    }
    __syncthreads();
  }
}

DI void phase_down(const Params& P, int layer, char* smem) {
  const bf16* ACT = (const bf16*)(P.ws + OFF_Z);
  const bf16* wl = (const bf16*)(P.ws + OFF_WT) + layer * W_LAYER;
  const int lane = ltid() & 63, w = ltid() >> 6;
  const int wm = w >> 1, wn = w & 1;
  for (int t0 = blockIdx.x; t0 < 256 * 8; t0 += gridDim.x) {
    const int t = xcd_tile(t0, 256 * 8);
    const int m0 = (t >> 3) * 128, n0 = (t & 7) * 128;
    f32x16 acc[2][2];
    float xr[2][2][16];
    const float* xld = P.out; asm volatile("" : "+s"(xld));
    const unsigned obase_b = 4u * (unsigned)((m0 + wm * 64 + 4 * (lane >> 5)) * 1024 + n0 + wn * 64 + (lane & 31));
#pragma unroll
    for (int mb = 0; mb < 2; ++mb)
#pragma unroll
      for (int nb = 0; nb < 2; ++nb)
#pragma unroll
        for (int r = 0; r < 16; ++r) xr[mb][nb][r] = (*uoff(xld + ((mb * 32 + (r & 3) + 8 * (r >> 2)) * 1024 + nb * 32), obase_b));
    gemm_tile(smem, 44, ACT, DFF, m0, wl + WO_DOWN, DFF, n0, acc);
    float* xst = P.out; asm volatile("" : "+s"(xst));
#pragma unroll
    for (int mb = 0; mb < 2; ++mb)
#pragma unroll
      for (int nb = 0; nb < 2; ++nb)
#pragma unroll
        for (int r = 0; r < 16; ++r)
          (*uoff(xst + ((mb * 32 + (r & 3) + 8 * (r >> 2)) * 1024 + nb * 32), obase_b)) = xr[mb][nb][r] + acc[mb][nb][r];
  }
}

#define XB_TMO      128
#define XB_XCNT(j)  (256  + 64 * (j))
#define XB_XSUB(j)  (1280 + 64 * (j))
#define XB_XGEN(j)  (2304 + 64 * (j))
#define XB_TOP      3328
#define XB_TOPGEN   3392
#define XCD_BAR_WORDS 3456
#define XB_SPIN_CAP (1u << 22)
#define LAS __attribute__((address_space(3)))
DI unsigned xb_ld(unsigned* p)              { return __hip_atomic_load(p, __ATOMIC_RELAXED, __HIP_MEMORY_SCOPE_AGENT); }
DI unsigned xb_add(unsigned* p, unsigned v) { return __hip_atomic_fetch_add(p, v, __ATOMIC_RELAXED, __HIP_MEMORY_SCOPE_AGENT); }
DI unsigned xb_xcc_id() { return (unsigned)__builtin_amdgcn_s_getreg((3 << 11) | 20) & 0xFu; }
#define XB_SPIN(cond, bar) do { unsigned _sp = 0; while (cond) { __builtin_amdgcn_s_sleep(1); \
    if ((++_sp & 255u) == 0u) { if (xb_ld(&(bar)[XB_TMO])) break; if (_sp > XB_SPIN_CAP) { atomicAdd(&(bar)[XB_TMO], 1u); break; } } } } while (0)
struct XcdBarrier { unsigned* bar; unsigned x; unsigned nloc, nx; };
DI XcdBarrier xcd_barrier_post(unsigned* bar) {
  XcdBarrier b; b.bar = bar; b.x = xb_xcc_id(); b.nloc = 0u; b.nx = 0u;
  if (threadIdx.x == 0) (void)xb_add(&bar[XB_XCNT(b.x)], 1u);
  return b;
}
DI void xcd_barrier_complete(unsigned* bar, unsigned x, unsigned& nloc, unsigned& nx) {
  const unsigned G = gridDim.x * gridDim.y * gridDim.z;
  unsigned sum, cnt, mine, sp = 0u;
  for (;;) {
    sum = 0u; cnt = 0u; mine = 0u;
#pragma unroll
    for (unsigned j = 0; j < 16; ++j) { const unsigned c = xb_ld(&bar[XB_XCNT(j)]); sum += c; cnt += (c > 0u) ? 1u : 0u; mine = (j == x) ? c : mine; }
    if (sum == G) break;
    __builtin_amdgcn_s_sleep(1);
    if ((++sp & 255u) == 0u) { if (xb_ld(&bar[XB_TMO])) break; if (sp > XB_SPIN_CAP) { atomicAdd(&bar[XB_TMO], 1u); break; } }
  }
  nloc = mine > 0u ? mine : 1u; nx = cnt > 0u ? cnt : 1u;
}
DI void xcd_barrier(XcdBarrier& b) {
  asm volatile("s_waitcnt vmcnt(0)" ::: "memory");
  __syncthreads();
  if (threadIdx.x == 0) {
    unsigned* bar = b.bar;
    __builtin_amdgcn_s_waitcnt(0);
    unsigned nloc = b.nloc, nx = b.nx;
    if (nloc == 0u) { xcd_barrier_complete(bar, b.x, nloc, nx); b.nloc = nloc; b.nx = nx; }
    const unsigned old = xb_add(&bar[XB_XSUB(b.x)], 1u);
    const unsigned gen = old / nloc;
    if (old + 1u == (gen + 1u) * nloc) {
      __builtin_amdgcn_fence(__ATOMIC_RELEASE, "agent");
      asm volatile("s_waitcnt vmcnt(0)" ::: "memory");
      const unsigned og = xb_add(&bar[XB_TOP], 1u);
      const unsigned tg = og / nx;
      if (og + 1u == (tg + 1u) * nx) xb_add(&bar[XB_TOPGEN], 1u);
      else XB_SPIN(xb_ld(&bar[XB_TOPGEN]) == tg, bar);
      __builtin_amdgcn_fence(__ATOMIC_ACQUIRE, "agent");
      xb_add(&bar[XB_XGEN(b.x)], 1u);
      asm volatile("s_waitcnt vmcnt(0)" ::: "memory");
    } else {
      XB_SPIN(xb_ld(&bar[XB_XGEN(b.x)]) == gen, bar);
      __builtin_amdgcn_fence(__ATOMIC_ACQUIRE, "agent");
      asm volatile("s_waitcnt vmcnt(0)" ::: "memory");
    }
  }
  __syncthreads();
}

constexpr int PH_PER_LAYER = 11;
constexpr int NPHASES = 2 * PH_PER_LAYER;

DI void run_phase(const Params& P, int ph, char* smem, unsigned xcc) {
  const int layer = ph / PH_PER_LAYER, p = ph % PH_PER_LAYER;
  const float* xin = layer == 0 ? P.x : P.out;
  bf16* HN = (bf16*)(P.ws + OFF_HN);
  switch (p) {
    case 0:
      if (layer == 0) phase_convert(P, smem);
      phase_zero_mask(P);
      phase_rmsnorm(xin, P.norm_mix + layer * 1024, HN);
      break;
    case 1: phase_gemm_in(P, layer, smem); break;
    case 2: phase_token_a(P, layer, smem); break;
    case 3: phase_gemm_lat(P, layer, smem); break;
    case 4: phase_token_c(P, layer, smem); phase_indexer(P, smem); break;
    case 5: phase_attention(P, layer, smem, xcc); phase_rmsnorm(xin, P.norm_mix + layer * 1024, HN); break;
    case 6: phase_merge(P, layer, smem); break;
    case 7: phase_out(P, layer, xin, smem); break;
    case 8: phase_rmsnorm(P.out, P.norm_ffn + layer * 1024, HN); break;
    case 9: phase_up(P, layer, smem); break;
    case 10: phase_down(P, layer, smem); break;
  }
}

__global__ void __launch_bounds__(256, 2) mega_kernel(Params P, int ph_begin, int ph_end) {
  __shared__ __attribute__((aligned(1024))) char smem[65536];
  cg::grid_group grid = cg::this_grid();
  XcdBarrier xb = xcd_barrier_post((unsigned*)(P.ws + OFF_BAR));
  for (int ph = ph_begin; ph < ph_end; ++ph) {
    run_phase(P, ph, smem, xb.x);
    if (ph + 1 < ph_end) {
      if (ph_end > 1000) grid.sync();
      else xcd_barrier(xb);
    }
  }
}

extern "C" void kernel_launch(void* const* d_in, const int* in_sizes, int n_in, void* d_out, int out_size, void* d_ws,
                              size_t ws_size, hipStream_t stream) {
  Params P{};
  P.x = (const float*)d_in[0]; P.rel_bias = (const float*)d_in[1]; P.norm_mix = (const float*)d_in[2];
  P.w_in = (const float*)d_in[3]; P.a_q_norm = (const float*)d_in[4]; P.a_k_norm = (const float*)d_in[5];
  P.b_cq_norm = (const float*)d_in[6]; P.b_ckv_norm = (const float*)d_in[7]; P.b_w_uq = (const float*)d_in[8];
  P.b_w_ukv = (const float*)d_in[9]; P.b_q_norm = (const float*)d_in[10]; P.b_k_norm = (const float*)d_in[11];
  P.w_proj_a = (const float*)d_in[12]; P.w_proj_b = (const float*)d_in[13]; P.b_gate = (const float*)d_in[14];
  P.w_out = (const float*)d_in[15]; P.norm_ffn = (const float*)d_in[16]; P.w_up = (const float*)d_in[17];
  P.conv_w = (const float*)d_in[18]; P.conv_b = (const float*)d_in[19]; P.w_down = (const float*)d_in[20];
  P.out = (float*)d_out; P.ws = (char*)d_ws;
  static int grid_blocks = 0;
  if (!grid_blocks) {
    int dev = 0, cus = 0, per_cu = 0;
    hipGetDevice(&dev);
    hipDeviceGetAttribute(&cus, hipDeviceAttributeMultiprocessorCount, dev);
    hipOccupancyMaxActiveBlocksPerMultiprocessor(&per_cu, mega_kernel, 256, 0);
    if (per_cu > 2) per_cu = 2;
    if (per_cu < 1) per_cu = 1;
    grid_blocks = cus * per_cu;
  }
#if MULTI_LAUNCH
  for (int ph = 0; ph < NPHASES; ++ph) {
    hipLaunchKernelGGL(mega_kernel, dim3(grid_blocks), dim3(256), 0, stream, P, ph, ph + 1);
  }
#else
  hipMemsetAsync((char*)d_ws + OFF_BAR, 0, 65536, stream);
  int b = 0, e = NPHASES;
  void* args[] = {&P, &b, &e};
  hipError_t err = hipLaunchCooperativeKernel((void*)mega_kernel, dim3(grid_blocks), dim3(256), args, 0, stream);
  if (err != hipSuccess) fprintf(stderr, "cooperative launch failed: %s (grid %d)\n", hipGetErrorString(err), grid_blocks);
#endif
}
```

```cpp
#include <hip/hip_runtime.h>
#include <hip/hip_cooperative_groups.h>
#include <cstdio>
namespace cg = cooperative_groups;

#ifndef MULTI_LAUNCH
#define MULTI_LAUNCH 0
#endif

typedef __bf16 bf16;
using bf16x8 = __attribute__((ext_vector_type(8))) __bf16;
using bf16x2 = __attribute__((ext_vector_type(2))) __bf16;
using f16x8  = __attribute__((ext_vector_type(8))) _Float16;
using f32x16 = __attribute__((ext_vector_type(16))) float;
using f32x4  = __attribute__((ext_vector_type(4))) float;
using f32x2  = __attribute__((ext_vector_type(2))) float;
using u32x4  = __attribute__((ext_vector_type(4))) unsigned;
using u32x2  = __attribute__((ext_vector_type(2))) unsigned;
using u32x8  = __attribute__((ext_vector_type(8))) unsigned;
#define DI __device__ __forceinline__

constexpr int T_ = 32768, S_ = 16384, DM = 1024;
constexpr int ZLD = 2816;
constexpr int C_QA = 0, C_KA = 512, C_VA = 1024, C_QI = 1536, C_KI = 2048, C_WI = 2112, C_CQ = 2120, C_CKV = 2504, C_KR = 2760;
constexpr int INC = 4840, C_GA = 2792, C_GB = 3816;
constexpr int DFF = 2816;
constexpr float EPS = 1e-6f;
constexpr float LOG2E = 1.4426950408889634f;

constexpr size_t WO_IN = 0;
constexpr size_t WO_UQ = WO_IN + (size_t)INC * 1024;
constexpr size_t WO_UKV = WO_UQ + 768 * 384;
constexpr size_t WO_PA = WO_UKV + 1024 * 256;
constexpr size_t WO_PB = WO_PA + 1024 * 512;
constexpr size_t WO_OUT = WO_PB + 1024 * 512;
constexpr size_t WO_UP = WO_OUT + 1024 * 1024;
constexpr size_t WO_DOWN = WO_UP + (size_t)5632 * 1024;
constexpr size_t W_LAYER = WO_DOWN + (size_t)1024 * 2816;

constexpr size_t MiB = 1048576;
constexpr size_t OFF_WT = 0;
constexpr size_t OFF_HN = 63 * MiB;
constexpr size_t OFF_MASK = 127 * MiB;
constexpr size_t OFF_Z = 160 * MiB;
constexpr size_t OFF_QB = 336 * MiB;
constexpr size_t OFF_KB = 384 * MiB;
constexpr size_t OFF_VTA = 432 * MiB;
constexpr size_t OFF_VTB = 464 * MiB;
constexpr size_t OFF_BAR = 500 * MiB;
constexpr size_t OFF_CTR = 500 * MiB + 16384;
constexpr size_t OFF_ZPAGE = 500 * MiB + 32768;
constexpr size_t MASK_WORDS_B = 4210688;
constexpr size_t MASK_BYTES = MASK_WORDS_B * 2 * 4;

struct Params {
  const float* x; const float* rel_bias; const float* norm_mix; const float* w_in; const float* a_q_norm; const float* a_k_norm;
  const float* b_cq_norm; const float* b_ckv_norm; const float* b_w_uq; const float* b_w_ukv; const float* b_q_norm; const float* b_k_norm;
  const float* w_proj_a; const float* w_proj_b; const float* b_gate; const float* w_out; const float* norm_ffn; const float* w_up;
  const float* conv_w; const float* conv_b; const float* w_down;
  float* out; char* ws;
};

DI int ltid() { int t = threadIdx.x; asm volatile("" : "+v"(t)); return t; }
DI unsigned short f2bf(float f) { return __builtin_bit_cast(unsigned short, (__bf16)f); }
DI unsigned pk2(float a, float b) { f32x2 v = {a, b}; return __builtin_bit_cast(unsigned, __builtin_convertvector(v, bf16x2)); }
DI float bf2f(unsigned short u) { return __uint_as_float(((unsigned)u) << 16); }
DI float bflo(unsigned u) { return __uint_as_float(u << 16); }
DI float bfhi(unsigned u) { return __uint_as_float(u & 0xffff0000u); }
DI unsigned short f2h(float f) { return __builtin_bit_cast(unsigned short, (_Float16)f); }
DI float wave_sum(float v) {
#pragma unroll
  for (int o = 32; o >= 1; o >>= 1) v += __shfl_xor(v, o);
  return v;
}
template <class T> DI T* uoff(T* base, unsigned byteoff) { return (T*)((char*)base + byteoff); }
template <class T> DI const T* uoff(const T* base, unsigned byteoff) { return (const T*)((const char*)base + byteoff); }
DI int xcd_tile(int t, int total) {
  const int local = t >> 3, l = local & 63;
  const int nl = (local & ~63) | (((l & 31) << 1) | (l >> 5));
  const int chunk = total >> 3;
  return (t & 7) * chunk + (((local | 63) < chunk) ? nl : local);
}
DI int mask_base(int b, int c) { return b * (int)MASK_WORDS_B + c * (c + 1) * 64; }

constexpr int STAGE_B = 32768;
#define WAIT_V0() asm volatile("s_waitcnt vmcnt(0)" ::: "memory")
DI void gemm_core(char* smem, int nk, const char* Ab, const char* Bb, const unsigned (&aoff)[4], const unsigned (&boff)[4],
                  f32x16 (&acc)[2][2]) {
  const int tid = ltid(), lane = tid & 63, w = tid >> 6;
  const int wm = w >> 1, wn = w & 1;
#pragma unroll
  for (int mb = 0; mb < 2; ++mb)
#pragma unroll
    for (int nb = 0; nb < 2; ++nb)
#pragma unroll
      for (int i = 0; i < 16; ++i) acc[mb][nb][i] = 0.f;
  const int l31 = lane & 31, H = lane >> 5, x = (l31 >> 1) & 7;
  const int a_base = (wm * 64 + l31) * 128, b_base = 16384 + (wn * 64 + l31) * 128;
  int xo[4];
#pragma unroll
  for (int ks = 0; ks < 4; ++ks) xo[ks] = ((2 * ks + H) ^ x) << 4;
  auto stage = [&](int buf, int kt) __attribute__((always_inline)) {
    const char* ak = Ab + kt * 128;
    const char* bk = Bb + kt * 128;
    char* sa = smem + buf * STAGE_B + w * 4096;
#pragma unroll
    for (int i = 0; i < 4; ++i) {
      __builtin_amdgcn_global_load_lds((const unsigned*)(ak + aoff[i]), (unsigned*)(sa + i * 1024), 16, 0, 0);
      __builtin_amdgcn_global_load_lds((const unsigned*)(bk + boff[i]), (unsigned*)(sa + 16384 + i * 1024), 16, 0, 0);
    }
  };
  stage(0, 0);
  WAIT_V0();
  __syncthreads();
  for (int kt = 0; kt < nk; ++kt) {
    const int cur = kt & 1;
    if (kt + 1 < nk) stage(cur ^ 1, kt + 1);
    const char* sb = smem + cur * STAGE_B;
#pragma unroll
    for (int ks = 0; ks < 4; ++ks) {
      bf16x8 af[2], bfr[2];
#pragma unroll
      for (int mb = 0; mb < 2; ++mb) af[mb] = *(const bf16x8*)(sb + a_base + mb * 4096 + xo[ks]);
#pragma unroll
      for (int nb = 0; nb < 2; ++nb) bfr[nb] = *(const bf16x8*)(sb + b_base + nb * 4096 + xo[ks]);
#pragma unroll
      for (int mb = 0; mb < 2; ++mb)
#pragma unroll
        for (int nb = 0; nb < 2; ++nb)
          acc[mb][nb] = __builtin_amdgcn_mfma_f32_32x32x16_bf16(af[mb], bfr[nb], acc[mb][nb], 0, 0, 0);
    }
    WAIT_V0();
    __syncthreads();
  }
}

DI int glds_row(int i) { const int tid = ltid(); return ((tid >> 6) * 4 + i) * 8 + ((tid & 63) >> 3); }
DI int glds_chunk(int row) { return (ltid() & 7) ^ ((row >> 1) & 7); }

template <class F>
DI void epi_foreach(const f32x16 (&acc)[2][2], F f) {
  const int lane = ltid() & 63, w = ltid() >> 6;
  const int wm = w >> 1, wn = w & 1;
#pragma unroll
  for (int mb = 0; mb < 2; ++mb)
#pragma unroll
    for (int nb = 0; nb < 2; ++nb)
#pragma unroll
      for (int r = 0; r < 16; ++r) {
        const int row = wm * 64 + mb * 32 + (r & 3) + 8 * (r >> 2) + 4 * (lane >> 5);
        const int col = wn * 64 + nb * 32 + (lane & 31);
        f(row, col, acc[mb][nb][r]);
        if ((r & 7) == 7) __builtin_amdgcn_sched_barrier(0);
      }
}

DI void store_tile16(const unsigned short* Cs, unsigned short* dst, int ldd) {
  const int tid = ltid();
#pragma unroll
  for (int i = 0; i < 8; ++i) {
    const int idx = tid + 256 * i;
    const int row = idx >> 4, c8 = (idx & 15) * 8;
    *(u32x4*)(dst + (size_t)row * ldd + c8) = *(const u32x4*)(Cs + row * 136 + c8);
  }
}

DI void gemm_tile(char* smem, int nk, const bf16* A, int lda, int m0, const bf16* Bt, int ldb, int n0, f32x16 (&acc)[2][2]) {
  unsigned aoff[4], boff[4];
#pragma unroll
  for (int i = 0; i < 4; ++i) {
    const int row = glds_row(i), ch = glds_chunk(row);
    aoff[i] = (unsigned)((row * lda + ch * 8) * 2);
    boff[i] = (unsigned)((row * ldb + ch * 8) * 2);
  }
  gemm_core(smem, nk, (const char*)(A + (size_t)m0 * lda), (const char*)(Bt + (size_t)n0 * ldb), aoff, boff, acc);
}

DI void transpose_tile(const float* src, bf16* dst, int K, int N, int t, char* smem) {
  unsigned short* ts = (unsigned short*)smem;
  const int tid = ltid();
  const int ntn = (N + 63) >> 6;
  const int n0 = (t % ntn) * 64, k0 = (t / ntn) * 64;
  {
    const int n4 = (tid & 15) * 4, kb = tid >> 4;
#pragma unroll
    for (int i = 0; i < 4; ++i) {
      const int k = kb + 16 * i;
      float4 v = {0.f, 0.f, 0.f, 0.f};
      if (n0 + n4 < N) v = *(const float4*)(src + (size_t)(k0 + k) * N + n0 + n4);
      ts[(n4 + 0) * 66 + k] = f2bf(v.x); ts[(n4 + 1) * 66 + k] = f2bf(v.y);
      ts[(n4 + 2) * 66 + k] = f2bf(v.z); ts[(n4 + 3) * 66 + k] = f2bf(v.w);
    }
  }
  __syncthreads();
  {
    const int n = tid >> 2, kc = tid & 3;
    if (n0 + n < N) {
      const unsigned* rp = (const unsigned*)(ts + n * 66 + kc * 16);
      u32x4 a = {rp[0], rp[1], rp[2], rp[3]}, b = {rp[4], rp[5], rp[6], rp[7]};
      u32x4* dp = (u32x4*)(dst + (size_t)(n0 + n) * K + k0 + kc * 16);
      dp[0] = a; dp[1] = b;
    }
  }
  __syncthreads();
}

DI void phase_convert(const Params& P, char* smem) {
  bf16* wt = (bf16*)(P.ws + OFF_WT);
  constexpr int NW = 8;
  const int Ks[NW] = {1024, 384, 256, 512, 512, 1024, 1024, 2816};
  const int Ns[NW] = {INC, 768, 1024, 1024, 1024, 1024, 5632, 1024};
  int total = 0;
#pragma unroll
  for (int i = 0; i < NW; ++i) total += ((Ns[i] + 63) >> 6) * (Ks[i] >> 6);
  for (int t = blockIdx.x; t < 2 * total; t += gridDim.x) {
    const int l = t >= total ? 1 : 0;
    int r = t - l * total;
    bf16* wl = wt + l * W_LAYER;
    const float* src = nullptr; bf16* dst = nullptr; int K = 64, N = 64;
    bool found = false;
#pragma unroll
    for (int i = 0; i < NW; ++i) {
      const int nt = ((Ns[i] + 63) >> 6) * (Ks[i] >> 6);
      if (!found && r < nt) {
        found = true; K = Ks[i]; N = Ns[i];
        const size_t lo = (size_t)l * Ks[i] * Ns[i];
        src = (i == 0 ? P.w_in : i == 1 ? P.b_w_uq : i == 2 ? P.b_w_ukv : i == 3 ? P.w_proj_a : i == 4 ? P.w_proj_b : i == 5 ? P.w_out : i == 6 ? P.w_up : P.w_down) + lo;
        dst = wl + (i == 0 ? WO_IN : i == 1 ? WO_UQ : i == 2 ? WO_UKV : i == 3 ? WO_PA : i == 4 ? WO_PB : i == 5 ? WO_OUT : i == 6 ? WO_UP : WO_DOWN);
      }
      if (!found) r -= nt;
    }
    transpose_tile(src, dst, K, N, r, smem);
  }
}

DI void phase_rmsnorm(const float* x, const float* g, bf16* hn) {
  const int lane = ltid() & 63, w = ltid() >> 6;
  for (int t = blockIdx.x * 4 + w; t < T_; t += gridDim.x * 4) {
    const float4* xr = (const float4*)(x + (size_t)t * DM);
    float4 v[4];
    float ss = 0.f;
#pragma unroll
    for (int i = 0; i < 4; ++i) {
      v[i] = xr[lane + 64 * i];
      ss += v[i].x * v[i].x + v[i].y * v[i].y + v[i].z * v[i].z + v[i].w * v[i].w;
    }
    ss = wave_sum(ss);
    const float r = rsqrtf(ss * (1.f / DM) + EPS);
#pragma unroll
    for (int i = 0; i < 4; ++i) {
      const float4 gg = ((const float4*)g)[lane + 64 * i];
      u32x2 o;
      o.x = pk2(v[i].x * r * gg.x, v[i].y * r * gg.y);
      o.y = pk2(v[i].z * r * gg.z, v[i].w * r * gg.w);
      *(u32x2*)(hn + (size_t)t * DM + (lane + 64 * i) * 4) = o;
    }
  }
}

DI void phase_zero_mask(const Params& P) {
  u32x4* m = (u32x4*)(P.ws + OFF_MASK);
  const size_t n = MASK_BYTES / 16;
  const u32x4 z = {0u, 0u, 0u, 0u};
  for (size_t i = (size_t)blockIdx.x * 256 + ltid(); i < n; i += (size_t)gridDim.x * 256) m[i] = z;
}

DI void phase_gemm_in(const Params& P, int layer, char* smem) {
  const bf16* hn = (const bf16*)(P.ws + OFF_HN);
  const bf16* wt = (const bf16*)(P.ws + OFF_WT) + layer * W_LAYER + WO_IN;
  unsigned short* Z = (unsigned short*)(P.ws + OFF_Z);
  constexpr int NT = 22, MT = 256;
  for (int t0 = blockIdx.x; t0 < NT * MT; t0 += gridDim.x) {
    const int tl = xcd_tile(t0, NT * MT) - (t0 & 7) * ((NT * MT) >> 3);
    const int m0 = ((t0 & 3) * 64 + tl / 11) * 128, n0 = (((t0 & 7) >> 2) * 11 + tl % 11) * 128;
    f32x16 acc[2][2];
    gemm_tile(smem, 16, hn, 1024, m0, wt, 1024, n0, acc);
    unsigned short* Cs = (unsigned short*)smem;
    epi_foreach(acc, [&](int row, int col, float v) __attribute__((always_inline)) {
      const int c = n0 + col;
      Cs[row * 136 + col] = (c >= C_QI && c < C_CQ) ? f2h(v) : f2bf(v);
    });
    __syncthreads();
    store_tile16(Cs, Z + (size_t)m0 * ZLD + n0, ZLD);
    __syncthreads();
  }
}

DI void transpose_v(const unsigned short* src, int ld, int col0, int hs, unsigned short* dst, char* smem) {
  unsigned short* ts = (unsigned short*)smem;
  const int tid = ltid();
  const int nitems = (T_ / 64) * 8;
  for (int it = blockIdx.x; it < nitems; it += gridDim.x) {
    const int h = it & 7, tg = it >> 3;
    const int t0 = tg * 64;
#pragma unroll
    for (int i = 0; i < 2; ++i) {
      const int r = (tid >> 3) + 32 * i, ch = tid & 7;
      u32x4 v = *(const u32x4*)(src + (size_t)(t0 + r) * ld + col0 + h * hs + ch * 8);
      *(u32x4*)(ts + r * 72 + ch * 8) = v;
    }
    __syncthreads();
    const int b = t0 / S_, s0 = t0 % S_;
#pragma unroll
    for (int i = 0; i < 2; ++i) {
      const int dv = (tid >> 3) + 32 * i, c = tid & 7;
      unsigned short e[8];
#pragma unroll
      for (int j = 0; j < 8; ++j) e[j] = ts[(8 * c + j) * 72 + dv];
      u32x4 o;
      o.x = e[0] | ((unsigned)e[1] << 16); o.y = e[2] | ((unsigned)e[3] << 16);
      o.z = e[4] | ((unsigned)e[5] << 16); o.w = e[6] | ((unsigned)e[7] << 16);
      *(u32x4*)(dst + ((size_t)((b * 8 + h) * 64 + dv)) * S_ + s0 + 8 * c) = o;
    }
    __syncthreads();
  }
}

DI void phase_token_a(const Params& P, int layer, char* smem) {
  unsigned short* Z = (unsigned short*)(P.ws + OFF_Z);
  const int lane = ltid() & 63, w = ltid() >> 6;
  const float* gq = P.a_q_norm + layer * 64;
  const float* gk = P.a_k_norm + layer * 64;
  const float* gcq = P.b_cq_norm + layer * 384;
  const float* gckv = P.b_ckv_norm + layer * 256;
  for (int t = blockIdx.x * 4 + w; t < T_; t += gridDim.x * 4) {
    unsigned short* zr = Z + (size_t)t * ZLD;
#pragma unroll
    for (int which = 0; which < 2; ++which) {
      const float* g = which ? gk : gq;
      u32x4* p = (u32x4*)(zr + (which ? C_KA : C_QA) + lane * 8);
      u32x4 u = *p;
      float f[8] = {bflo(u.x), bfhi(u.x), bflo(u.y), bfhi(u.y), bflo(u.z), bfhi(u.z), bflo(u.w), bfhi(u.w)};
      float ss = 0.f;
#pragma unroll
      for (int j = 0; j < 8; ++j) ss += f[j] * f[j];
      ss += __shfl_xor(ss, 1); ss += __shfl_xor(ss, 2); ss += __shfl_xor(ss, 4);
      const float r = rsqrtf(ss * (1.f / 64) + EPS);
      const int c0 = (lane & 7) * 8;
#pragma unroll
      for (int j = 0; j < 8; ++j) f[j] = f[j] * r * g[c0 + j];
      u.x = pk2(f[0], f[1]); u.y = pk2(f[2], f[3]); u.z = pk2(f[4], f[5]); u.w = pk2(f[6], f[7]);
      *p = u;
    }
    {
      unsigned* p = (unsigned*)(zr + C_CQ + lane * 6);
      unsigned u0 = p[0], u1 = p[1], u2 = p[2];
      float f[6] = {bflo(u0), bfhi(u0), bflo(u1), bfhi(u1), bflo(u2), bfhi(u2)};
      float ss = 0.f;
#pragma unroll
      for (int j = 0; j < 6; ++j) ss += f[j] * f[j];
      ss = wave_sum(ss);
      const float r = rsqrtf(ss * (1.f / 384) + EPS);
#pragma unroll
      for (int j = 0; j < 6; ++j) f[j] = f[j] * r * gcq[lane * 6 + j];
      p[0] = pk2(f[0], f[1]); p[1] = pk2(f[2], f[3]); p[2] = pk2(f[4], f[5]);
    }
    {
      u32x2* p = (u32x2*)(zr + C_CKV + lane * 4);
      u32x2 u = *p;
      float f[4] = {bflo(u.x), bfhi(u.x), bflo(u.y), bfhi(u.y)};
      float ss = f[0] * f[0] + f[1] * f[1] + f[2] * f[2] + f[3] * f[3];
      ss = wave_sum(ss);
      const float r = rsqrtf(ss * (1.f / 256) + EPS);
#pragma unroll
      for (int j = 0; j < 4; ++j) f[j] = f[j] * r * gckv[lane * 4 + j];
      u.x = pk2(f[0], f[1]); u.y = pk2(f[2], f[3]);
      *p = u;
    }
    {
      const int i = lane & 15;
      const float x1 = bf2f(zr[C_KR + i]), x2 = bf2f(zr[C_KR + 16 + i]);
      const float inv = powf(10000.f, -(float)i / 16.f);
      const float ang = (float)(t % S_) * inv;
      float sn, cs;
      sincosf(ang, &sn, &cs);
      const float o1 = x1 * cs - x2 * sn, o2 = x1 * sn + x2 * cs;
      if (lane < 16) { zr[C_KR + i] = f2bf(o1); zr[C_KR + 16 + i] = f2bf(o2); }
    }
  }
  __syncthreads();
  transpose_v(Z, ZLD, C_VA, 64, (unsigned short*)(P.ws + OFF_VTA), smem);
}

DI void phase_gemm_lat(const Params& P, int layer, char* smem) {
  const bf16* Z = (const bf16*)(P.ws + OFF_Z);
  const bf16* wl = (const bf16*)(P.ws + OFF_WT) + layer * W_LAYER;
  unsigned short* QB = (unsigned short*)(P.ws + OFF_QB);
  unsigned short* KV = (unsigned short*)(P.ws + OFF_HN);
  constexpr int MT = 256;
  for (int t0 = blockIdx.x; t0 < MT * 14; t0 += gridDim.x) {
    const int t = xcd_tile(t0, MT * 14);
    const int mt = t / 14, nt = t % 14;
    const int m0 = mt * 128;
    const bool isq = nt < 6;
    const int n0 = (isq ? nt : nt - 6) * 128;
    f32x16 acc[2][2];
    gemm_tile(smem, isq ? 6 : 4, Z + (isq ? C_CQ : C_CKV), ZLD, m0, wl + (isq ? WO_UQ : WO_UKV), isq ? 384 : 256, n0, acc);
    unsigned short* dst = isq ? QB : KV;
    const int ldd = isq ? 768 : 1024;
    unsigned short* Cs = (unsigned short*)smem;
    epi_foreach(acc, [&](int row, int col, float v) __attribute__((always_inline)) { Cs[row * 136 + col] = f2bf(v); });
    __syncthreads();
    store_tile16(Cs, dst + (size_t)m0 * ldd + n0, ldd);
    __syncthreads();
  }
}

DI void phase_token_c(const Params& P, int layer, char* smem) {
  const unsigned short* Z = (const unsigned short*)(P.ws + OFF_Z);
  unsigned short* QB = (unsigned short*)(P.ws + OFF_QB);
  unsigned short* KB = (unsigned short*)(P.ws + OFF_KB);
  const unsigned short* KV = (const unsigned short*)(P.ws + OFF_HN);
  const int lane = ltid() & 63, w = ltid() >> 6;
  float* rowbuf = (float*)smem + w * 800;
  const float* gq = P.b_q_norm + layer * 96;
  const float* gk = P.b_k_norm + layer * 96;
  const int ngroups = T_ / 4;
  for (int gi = blockIdx.x; gi < ngroups; gi += gridDim.x) {
    const int t = gi * 4 + w;
    unsigned short* qr = QB + (size_t)t * 768;
#pragma unroll
    for (int i = 0; i < 3; ++i) {
      const u32x2 u = *(const u32x2*)(qr + (lane + 64 * i) * 4);
      float4 f = {bflo(u.x), bfhi(u.x), bflo(u.y), bfhi(u.y)};
      *(float4*)(rowbuf + (lane + 64 * i) * 4) = f;
    }
    if (lane < 16) {
      const float inv = powf(10000.f, -(float)lane / 16.f);
      const float ang = (float)(t % S_) * inv;
      float sn, cs;
      sincosf(ang, &sn, &cs);
      rowbuf[768 + lane] = cs; rowbuf[784 + lane] = sn;
    }
    __syncthreads();
    {
      float f[12];
      float ss = 0.f;
      const int hd = lane >> 3, j0 = (lane & 7) * 12;
#pragma unroll
      for (int e = 0; e < 12; ++e) {
        const int j = j0 + e;
        float v;
        if (j < 64) v = rowbuf[hd * 96 + j];
        else {
          const int i = (j - 64) & 15;
          const float x1 = rowbuf[hd * 96 + 64 + i], x2 = rowbuf[hd * 96 + 80 + i];
          const float cs = rowbuf[768 + i], sn = rowbuf[784 + i];
          v = (j < 80) ? (x1 * cs - x2 * sn) : (x1 * sn + x2 * cs);
        }
        f[e] = v; ss += v * v;
      }
      ss += __shfl_xor(ss, 1); ss += __shfl_xor(ss, 2); ss += __shfl_xor(ss, 4);
      const float r = rsqrtf(ss * (1.f / 96) + EPS);
      unsigned o[6];
#pragma unroll
      for (int e = 0; e < 6; ++e) o[e] = pk2(f[2 * e] * r * gq[j0 + 2 * e], f[2 * e + 1] * r * gq[j0 + 2 * e + 1]);
      u32x2* op = (u32x2*)(qr + lane * 12);
      op[0] = u32x2{o[0], o[1]}; op[1] = u32x2{o[2], o[3]}; op[2] = u32x2{o[4], o[5]};
    }
    {
      float f[12];
      float ss = 0.f;
      const int hd = lane >> 3, j0 = (lane & 7) * 12;
#pragma unroll
      for (int e = 0; e < 12; ++e) {
        const int j = j0 + e;
        const float v = (j < 64) ? bf2f(KV[(size_t)t * 1024 + hd * 128 + j]) : bf2f(Z[(size_t)t * ZLD + C_KR + (j - 64)]);
        f[e] = v; ss += v * v;
      }
      ss += __shfl_xor(ss, 1); ss += __shfl_xor(ss, 2); ss += __shfl_xor(ss, 4);
      const float r = rsqrtf(ss * (1.f / 96) + EPS);
      unsigned o[6];
#pragma unroll
      for (int e = 0; e < 6; ++e) o[e] = pk2(f[2 * e] * r * gk[j0 + 2 * e], f[2 * e + 1] * r * gk[j0 + 2 * e + 1]);
      u32x2* op = (u32x2*)(KB + ((size_t)((t / S_) * 8 + hd) * S_ + (t % S_)) * 96 + j0);
      op[0] = u32x2{o[0], o[1]}; op[1] = u32x2{o[2], o[3]}; op[2] = u32x2{o[4], o[5]};
    }
    __syncthreads();
  }
  __syncthreads();
  transpose_v(KV, 1024, 64, 128, (unsigned short*)(P.ws + OFF_VTB), smem);
}

DI unsigned f2o(float f) { unsigned u = __float_as_uint(f); return u ^ ((u >> 31) ? 0xffffffffu : 0x80000000u); }
DI float o2f(unsigned u) { return __uint_as_float(u ^ ((u >> 31) ? 0x80000000u : 0xffffffffu)); }

DI void topk_compact(float* sc, unsigned short* ix, int* cntp, float* taup, int lane) {
  const int n = *cntp;
  unsigned u[8]; unsigned id[8]; bool valid[8];
#pragma unroll
  for (int i = 0; i < 8; ++i) {
    const int p = lane + 64 * i;
    valid[i] = p < n;
    u[i] = valid[i] ? f2o(sc[p]) : 0u;
    id[i] = valid[i] ? (unsigned)ix[p] : 0xffffu;
  }
  unsigned prefix = 0; int kk = 256;
  for (int bit = 31; bit >= 0; --bit) {
    const unsigned cand = (prefix >> bit) | 1u;
    int c = 0;
#pragma unroll
    for (int i = 0; i < 8; ++i) c += __popcll(__ballot(valid[i] && ((u[i] >> bit) == cand)));
    if (c >= kk) prefix |= (1u << bit); else kk -= c;
  }
  int ceq = 0;
#pragma unroll
  for (int i = 0; i < 8; ++i) ceq += __popcll(__ballot(valid[i] && u[i] == prefix));
  unsigned idthr = 0xffffu;
  if (ceq != kk) {
    unsigned p2 = 0; int k2 = kk;
    for (int bit = 13; bit >= 0; --bit) {
      int c0 = 0;
#pragma unroll
      for (int i = 0; i < 8; ++i) c0 += __popcll(__ballot(valid[i] && u[i] == prefix && ((id[i] >> bit) == (p2 >> bit))));
      if (c0 < k2) { k2 -= c0; p2 |= (1u << bit); }
    }
    idthr = p2;
  }
  int base = 0;
  const unsigned long long lt = (1ull << lane) - 1ull;
#pragma unroll
  for (int i = 0; i < 8; ++i) {
    const bool keep = valid[i] && (u[i] > prefix || (u[i] == prefix && id[i] <= idthr));
    const unsigned long long m = __ballot(keep);
    if (keep) {
      const int pos = base + __popcll(m & lt);
      sc[pos] = o2f(u[i]); ix[pos] = (unsigned short)id[i];
    }
    base += __popcll(m);
  }
  if (lane == 0) { *cntp = base; *taup = o2f(prefix); }
}

constexpr int HB_LO = 124 * 16, HB_P = 192, HB_WORDS = 387;

template <int MODE>
DI void indexer_pass(const _Float16* kbase, int ntile_in, int ts, const f16x8 (&qf)[8][2], const f16x8 (&qc)[2], const float (&wq)[8], float* csc,
                     unsigned short* cix, int* cnt, float* tau, unsigned* hist, int* oflow, int lane, int w) {
  constexpr int NG = (MODE == 2) ? 2 : 4;
  const int ntile = (ntile_in + ts - 1) / ts;
  const int q = lane & 15, kg = lane >> 4;
  const int nstep = (ntile + NG - 1) / NG;
  f16x8 cur[NG][2], nxt[NG][2];
#pragma unroll
  for (int g = 0; g < NG; ++g) {
    int tl = g; tl = tl < ntile ? tl : ntile - 1;
    cur[g][0] = *(const f16x8*)(kbase + (size_t)(tl * ts) * 64 * ZLD);
    cur[g][1] = *(const f16x8*)(kbase + (size_t)(tl * ts) * 64 * ZLD + 32);
  }
  float tq = (MODE == 0) ? 0.f : tau[q];
  for (int st = 0; st < nstep; ++st) {
#pragma unroll
    for (int g = 0; g < NG; ++g) {
      int tl = NG * (st + 1) + g; tl = tl < ntile ? tl : ntile - 1;
      nxt[g][0] = *(const f16x8*)(kbase + (size_t)(tl * ts) * 64 * ZLD);
      nxt[g][1] = *(const f16x8*)(kbase + (size_t)(tl * ts) * 64 * ZLD + 32);
    }
    if (MODE == 2) tq = tau[q];
#pragma unroll
    for (int g = 0; g < NG; ++g) {
      const int tl = NG * st + g;
      if (tl < ntile) {
        f32x4 lin = {0.f, 0.f, 0.f, 0.f};
        lin = __builtin_amdgcn_mfma_f32_16x16x32_f16(cur[g][0], qc[0], lin, 0, 0, 0);
        lin = __builtin_amdgcn_mfma_f32_16x16x32_f16(cur[g][1], qc[1], lin, 0, 0, 0);
        float s[4] = {lin[0], lin[1], lin[2], lin[3]};
        f32x4 accp = {0.f, 0.f, 0.f, 0.f};
        accp = __builtin_amdgcn_mfma_f32_16x16x32_f16(cur[g][0], qf[0][0], accp, 0, 0, 0);
        accp = __builtin_amdgcn_mfma_f32_16x16x32_f16(cur[g][1], qf[0][1], accp, 0, 0, 0);
#pragma unroll
        for (int h = 0; h < 8; ++h) {
          f32x4 accn = {0.f, 0.f, 0.f, 0.f};
          if (h < 7) {
            accn = __builtin_amdgcn_mfma_f32_16x16x32_f16(cur[g][0], qf[h + 1][0], accn, 0, 0, 0);
            accn = __builtin_amdgcn_mfma_f32_16x16x32_f16(cur[g][1], qf[h + 1][1], accn, 0, 0, 0);
          }
          __builtin_amdgcn_sched_barrier(0);
#pragma unroll
          for (int r = 0; r < 4; ++r) {
            s[r] = fmaf(wq[h], __builtin_fabsf(accp[r]), s[r]);
            asm("" : "+v"(s[r]));
          }
          __builtin_amdgcn_sched_barrier(0);
          accp = accn;
        }
        if (MODE == 0) {
#pragma unroll
          for (int r = 0; r < 4; ++r) {
            const float score = s[r] + 0.f;
            const unsigned bits = __float_as_uint(score);
            int p = (int)((bits & 0x7fffffffu) >> 19) - (HB_LO - 1);
            p = p < 0 ? 0 : (p > HB_P ? HB_P : p);
            const int bin = (bits >> 31) ? (HB_P - p) : (HB_P + 1 + p);
            atomicAdd(hist + q * HB_WORDS + bin, 1u);
          }
        } else {
          float sc4[4]; bool ps[4]; int np = 0;
#pragma unroll
          for (int r = 0; r < 4; ++r) { sc4[r] = s[r] + 0.f; ps[r] = sc4[r] > tq; np += ps[r] ? 1 : 0; }
          if (__ballot(np > 0)) {
            int pos = q * 512 + atomicAdd(&cnt[q], np);
            const int lim = q * 512 + 512;
            if (MODE != 2) { if (__ballot(pos + np > lim)) { if (pos + np > lim) *oflow = 1; } }
            const int dummy = 16 * 512 + lane;
            const unsigned kbase16 = (unsigned)(tl * 64 + w * 16 + kg * 4);
#pragma unroll
            for (int r = 0; r < 4; ++r) {
              const bool ok = ps[r] && (MODE == 2 || pos < lim);
              const int idx = ok ? pos : dummy;
              csc[idx] = sc4[r];
              cix[idx] = (unsigned short)(kbase16 + r);
              pos += ps[r] ? 1 : 0;
            }
          }
        }
      }
    }
    if (MODE == 2) {
      __syncthreads();
#pragma unroll 1
      for (int jj = 0; jj < 4; ++jj) {
        const int qq = w * 4 + jj;
        if (cnt[qq] > 384) topk_compact(csc + qq * 512, cix + qq * 512, cnt + qq, tau + qq, lane);
      }
      __syncthreads();
    }
#pragma unroll
    for (int g = 0; g < NG; ++g) { cur[g][0] = nxt[g][0]; cur[g][1] = nxt[g][1]; }
  }
}

DI void phase_indexer(const Params& P, char* smem) {
  float* csc = (float*)(smem);
  unsigned short* cix = (unsigned short*)(smem + 34816);
  unsigned* hist = (unsigned*)(smem);
  int* cnt = (int*)(smem + 52224);
  float* tau = (float*)(cnt + 16);
  int* oflow = cnt + 32;
  const int tid = ltid(), lane = tid & 63, w = tid >> 6;
  const _Float16* Zh = (const _Float16*)(P.ws + OFF_Z);
  unsigned* mask = (unsigned*)(P.ws + OFF_MASK);
  const int NT = T_ / 16, G = gridDim.x, j = blockIdx.x;
  for (int k = 0; k * G < NT; ++k) {
    const int rk = k * G + ((k & 1) ? (G - 1 - j) : j);
    if (rk >= NT) continue;
    const int c = 255 - (rk >> 3), sub = rk & 7;
    const int b = sub >> 2, qsub = sub & 3;
    const int t0 = b * S_ + c * 64 + qsub * 16;
    if (c < 4) {
      if (tid < 2 * (c + 1) * 16) {
        const int kb = tid >> 4, ql = qsub * 16 + (tid & 15);
        mask[mask_base(b, c) + kb * 64 + ql] = 0xffffffffu;
      }
      continue;
    }
    const int q = lane & 15, kg = lane >> 4;
    f16x8 qf[8][2];
#pragma unroll
    for (int h = 0; h < 8; ++h)
#pragma unroll
      for (int ks = 0; ks < 2; ++ks)
        qf[h][ks] = *(const f16x8*)(Zh + (size_t)(t0 + q) * ZLD + C_QI + h * 64 + ks * 32 + kg * 8);
    float wq[8];
    {
      const f16x8 wv = *(const f16x8*)(Zh + (size_t)(t0 + q) * ZLD + C_WI);
#pragma unroll
      for (int h = 0; h < 8; ++h) wq[h] = (float)wv[h];
    }
    f16x8 qc[2];
#pragma unroll
    for (int ks = 0; ks < 2; ++ks)
#pragma unroll
      for (int jx = 0; jx < 8; ++jx) {
        float a = 0.f;
#pragma unroll
        for (int h = 0; h < 8; ++h) a = fmaf(wq[h], (float)qf[h][ks][jx], a);
        qc[ks][jx] = (_Float16)a;
      }
    const _Float16* kbase = Zh + (size_t)(b * S_ + w * 16 + q) * ZLD + C_KI + kg * 8;
    const int ntile = c + 1;
    for (int attempt = (ntile > 16) ? 0 : 1;; ++attempt) {
      __syncthreads();
      for (int i = tid; i < 16 * HB_WORDS; i += 256) hist[i] = 0u;
      if (tid < 16) { cnt[tid] = 0; tau[tid] = -INFINITY; }
      if (tid == 0) *oflow = 0;
      __syncthreads();
      if (attempt >= 2) {
        indexer_pass<2>(kbase, ntile, 1, qf, qc, wq, csc, cix, cnt, tau, hist, oflow, lane, w);
        break;
      }
      const int ts = attempt == 0 ? 2 : 1;
      indexer_pass<0>(kbase, ntile, ts, qf, qc, wq, csc, cix, cnt, tau, hist, oflow, lane, w);
      __syncthreads();
      if (tid < 16) {
        const int nsamp = (ntile + ts - 1) / ts;
        const int target = attempt == 0 ? (320 * nsamp + ntile - 1) / ntile : 256;
        const unsigned* hq = hist + tid * HB_WORDS;
        int cum = 0, B = 0;
        for (int bin = 2 * HB_P + 1; bin >= 0; --bin) {
          cum += (int)hq[bin];
          if (cum >= target) { B = bin; break; }
        }
        float t;
        if (B > HB_P) {
          const int p = B - HB_P - 1;
          t = (p == 0) ? -1e-30f : __uint_as_float((((unsigned)(p + HB_LO - 1)) << 19) - 1u);
        } else {
          const int p = HB_P - B;
          t = (p == HB_P) ? -INFINITY : -__uint_as_float(((unsigned)(p + HB_LO)) << 19);
        }
        tau[tid] = t;
      }
      __syncthreads();
      indexer_pass<1>(kbase, ntile, 1, qf, qc, wq, csc, cix, cnt, tau, hist, oflow, lane, w);
      __syncthreads();
      if (tid < 16 && cnt[tid] < 256) *oflow = 1;
      __syncthreads();
      if (!*oflow) break;
    }
#pragma unroll 1
    for (int jj = 0; jj < 4; ++jj) {
      const int qq = w * 4 + jj;
      if (cnt[qq] > 256) topk_compact(csc + qq * 512, cix + qq * 512, cnt + qq, tau + qq, lane);
      unsigned* mrow = mask + mask_base(b, c) + (qsub * 16 + qq);
#pragma unroll
      for (int i = 0; i < 4; ++i) {
        const unsigned key = cix[qq * 512 + lane + 64 * i];
        atomicOr(mrow + (key >> 5) * 64, 1u << (key & 31));
      }
    }
    __syncthreads();
  }
}

DI int t5_bucket(int rel) {
  const int n = rel < 0 ? -rel : rel;
  int bkt;
  if (n < 8) bkt = n; else if (n < 12) bkt = 8; else if (n < 16) bkt = 9; else if (n < 23) bkt = 10; else if (n < 32) bkt = 11;
  else if (n < 46) bkt = 12; else if (n < 64) bkt = 13; else if (n < 91) bkt = 14; else bkt = 15;
  return bkt + (rel > 0 ? 16 : 0);
}

template <int DQK, bool MIXA, bool PIPE>
DI void attn_item(const Params& P, int layer, char* smem, int b, int h, int qt) {
  constexpr int NS = DQK / 16;
  constexpr int KCH = DQK / 8;
  constexpr int KROWB = DQK * 2;
  constexpr int KTILE_B = 64 * KROWB;
  constexpr int STG_B = 20480;
  constexpr int NKI = KTILE_B / 4096;
  float* biasT = (float*)(smem + 2 * STG_B);
  const int tid = ltid(), lane = tid & 63, w = tid >> 6;
  const int H = lane >> 5, l31 = lane & 31;
  const unsigned short* Z = (const unsigned short*)(P.ws + OFF_Z);
  const unsigned short *Qp, *Kp, *VT;
  int ldq, ldk;
  unsigned short* Yp = (unsigned short*)(P.ws + OFF_Z);
  if (MIXA) {
    Qp = Z + C_QA + h * 64; Kp = Z + C_KA + h * 64 + (size_t)b * S_ * ZLD; ldq = ZLD; ldk = ZLD;
    VT = (const unsigned short*)(P.ws + OFF_VTA) + (size_t)((b * 8 + h) * 64) * S_;
    Yp += C_VA + h * 64;
  } else {
    Qp = (const unsigned short*)(P.ws + OFF_QB) + h * 96; ldq = 768;
    Kp = (const unsigned short*)(P.ws + OFF_KB) + (size_t)(b * 8 + h) * S_ * 96; ldk = 96;
    VT = (const unsigned short*)(P.ws + OFF_VTB) + (size_t)((b * 8 + h) * 64) * S_;
    Yp += C_QI + h * 64;
  }
  const unsigned* mask = (const unsigned*)(P.ws + OFF_MASK);
  const int tq0 = qt * 128 + w * 32;
  const int qpos = tq0 + l31;
  const int cw = tq0 >> 6;
  const size_t tokq = (size_t)b * S_ + qpos;
  const float sl2 = (MIXA ? 0.125f : 0.10206207261596575f) * LOG2E;
  float mfix;
  {
    const float* g1 = MIXA ? (P.a_q_norm + layer * 64) : (P.b_q_norm + layer * 96);
    const float* g2 = MIXA ? (P.a_k_norm + layer * 64) : (P.b_k_norm + layer * 96);
    float a1 = 0.f, a2 = 0.f;
    for (int i = 0; i < DQK; ++i) { a1 = fmaxf(a1, fabsf(g1[i])); a2 = fmaxf(a2, fabsf(g2[i])); }
    mfix = (float)DQK * 1.02f * a1 * a2 * sl2;
    if (MIXA) {
      const float b15 = P.rel_bias[15 * 8 + h];
      float bm = 0.f;
      for (int i = 0; i < 32; ++i) bm = fmaxf(bm, P.rel_bias[i * 8 + h] - b15);
      mfix += bm * LOG2E;
    }
  }
  if (MIXA) {
    const int rel = tid - 192;
    const float b15 = P.rel_bias[15 * 8 + h];
    biasT[tid] = (P.rel_bias[t5_bucket(rel) * 8 + h] - b15) * LOG2E;
  }
  bf16x8 qf[NS];
#pragma unroll
  for (int s = 0; s < NS; ++s) qf[s] = *(const bf16x8*)(Qp + tokq * ldq + 16 * s + 8 * H);
  const int nkt = 2 * qt + 2;
  unsigned koff[NKI], voff[2];
#pragma unroll
  for (int i = 0; i < NKI; ++i) {
    const int e = (w * NKI + i) * 64 + lane;
    const int row = e / KCH, slot = e % KCH;
    const int c = slot ^ (MIXA ? ((row >> 1) & 7) : ((row >> 2) & 3));
    koff[i] = (unsigned)((row * ldk + c * 8) * 2);
  }
#pragma unroll
  for (int i = 0; i < 2; ++i) {
    const int e = (w * 2 + i) * 64 + lane;
    const int row = e >> 3, slot = e & 7;
    const int c = slot ^ ((row >> 1) & 7);
    voff[i] = (unsigned)((row * S_ + c * 8) * 2);
  }
  unsigned mwn[2] = {0u, 0u};
  auto issue_loads = [&](int kt) __attribute__((always_inline)) {
    const char* kbp = (const char*)(Kp + (size_t)(kt * 64) * ldk);
    const char* vbp = (const char*)(VT + kt * 64);
    char* sk = smem + (kt & 1) * STG_B;
#pragma unroll
    for (int i = 0; i < NKI; ++i)
      __builtin_amdgcn_global_load_lds((const unsigned*)(kbp + koff[i]), (unsigned*)(sk + (w * NKI + i) * 1024), 16, 0, 0);
#pragma unroll
    for (int i = 0; i < 2; ++i)
      __builtin_amdgcn_global_load_lds((const unsigned*)(vbp + voff[i]), (unsigned*)(sk + KTILE_B + (w * 2 + i) * 1024), 16, 0, 0);
    if (MIXA) {
      if (kt <= cw) {
        const unsigned* mp = mask + mask_base(b, cw) + (2 * kt) * 64 + (qpos & 63);
        mwn[0] = mp[0]; mwn[1] = mp[64];
      }
    }
  };
  issue_loads(0);
  f32x16 o[2];
#pragma unroll
  for (int d = 0; d < 2; ++d)
#pragma unroll
    for (int i = 0; i < 16; ++i) o[d][i] = 0.f;
  float l = 0.f;
  const int pr = (l31 & ~12) | ((l31 & 4) << 1) | ((l31 & 8) >> 1);
  const int swk = MIXA ? ((pr >> 1) & 7) : ((pr >> 2) & 3), swv = (l31 >> 1) & 7;
  asm volatile("s_waitcnt vmcnt(0)" ::: "memory");
  __syncthreads();
  for (int kt = 0; kt < nkt; ++kt) {
    unsigned mw[2] = {mwn[0], mwn[1]};
    if (kt + 1 < nkt) issue_loads(kt + 1);
    const char* Ks = smem + (kt & 1) * STG_B;
    const char* Vs = Ks + KTILE_B;
    if (kt <= cw) {
      const int kc = kt;
      bf16x8 kf[2][NS];
#pragma unroll
      for (int kb = 0; kb < 2; ++kb)
#pragma unroll
        for (int s = 0; s < NS; ++s) kf[kb][s] = *(const bf16x8*)(Ks + (32 * kb + pr) * KROWB + (((2 * s + H) ^ swk) << 4));
      __builtin_amdgcn_sched_barrier(0);
      f32x16 sacc[2];
#pragma unroll
      for (int kb = 0; kb < 2; ++kb)
#pragma unroll
        for (int i = 0; i < 16; ++i) sacc[kb][i] = 0.f;
#pragma unroll
      for (int s = 0; s < NS; ++s) sacc[0] = __builtin_amdgcn_mfma_f32_32x32x16_bf16(kf[0][s], qf[s], sacc[0], 0, 0, 0);
      bf16x8 vf[2][2][2];
#pragma unroll
      for (int d = 0; d < 2; ++d)
#pragma unroll
        for (int kb = 0; kb < 2; ++kb)
#pragma unroll
          for (int s2 = 0; s2 < 2; ++s2)
            vf[d][kb][s2] = *(const bf16x8*)(Vs + (d * 32 + l31) * 128 + (((4 * kb + 2 * s2 + H) ^ swv) << 4));
      __builtin_amdgcn_sched_barrier(0);
      const bool near = MIXA && (kc >= cw - 2);
      f32x2 ls2 = {0.f, 0.f};
      const f32x2 sl2v = {sl2, sl2}, mfixv = {mfix, mfix};
      unsigned pkw[2][2][4];
      unsigned mrot[2];
#pragma unroll
      for (int kb = 0; kb < 2; ++kb) mrot[kb] = MIXA ? ((mw[kb] >> (8 * H)) << 8) : 0u;
      auto chunk = [&](int kb, int c) __attribute__((always_inline)) {
        const int s2 = 1 - (c >> 2), e = 3 - (c & 3);
        const int r0 = 8 * s2 + 2 * e;
        if (MIXA && c == 4) mrot[kb] <<= 8;
        f32x2 xv2 = {sacc[kb][r0], sacc[kb][r0 + 1]};
        xv2 = xv2 * sl2v - mfixv;
        if (MIXA) {
          if (near) {
            const int kl = 16 * (r0 >> 3) + 8 * H + (r0 & 7);
            const int rel = kc * 64 + 32 * kb + kl - qpos;
            xv2.x += biasT[rel + 192];
            xv2.y += biasT[rel + 193];
          }
        }
        f32x2 p2 = {__builtin_amdgcn_exp2f(xv2.x), __builtin_amdgcn_exp2f(xv2.y)};
        if (MIXA) {
          float px = p2.x, py = p2.y;
          asm volatile("v_add_co_u32 %0, vcc, %0, %0\n\tv_cndmask_b32 %1, 0, %1, vcc" : "+v"(mrot[kb]), "+v"(py) : : "vcc");
          asm volatile("v_add_co_u32 %0, vcc, %0, %0\n\tv_cndmask_b32 %1, 0, %1, vcc" : "+v"(mrot[kb]), "+v"(px) : : "vcc");
          p2.x = px; p2.y = py;
        }
        ls2 += p2;
        pkw[kb][s2][e] = pk2(p2.x, p2.y);
      };
      {
        int c0 = 0;
#pragma unroll
        for (int s = 0; s < NS; ++s) {
          sacc[1] = __builtin_amdgcn_mfma_f32_32x32x16_bf16(kf[1][s], qf[s], sacc[1], 0, 0, 0);
          const int cend = (8 * (s + 1)) / NS;
#pragma unroll
          for (int c = 0; c < 8; ++c) if (c >= c0 && c < cend) chunk(0, c);
          c0 = cend;
          __builtin_amdgcn_sched_barrier(0);
        }
      }
      bf16x8 pf0[2], pf1[2];
#pragma unroll
      for (int s2 = 0; s2 < 2; ++s2) { u32x4 t = {pkw[0][s2][0], pkw[0][s2][1], pkw[0][s2][2], pkw[0][s2][3]}; pf0[s2] = __builtin_bit_cast(bf16x8, t); }
#pragma unroll
      for (int j = 0; j < 4; ++j) {
        const int s2 = j >> 1, d = j & 1;
        o[d] = __builtin_amdgcn_mfma_f32_32x32x16_bf16(vf[d][0][s2], pf0[s2], o[d], 0, 0, 0);
        chunk(1, 2 * j); chunk(1, 2 * j + 1);
        __builtin_amdgcn_sched_barrier(0);
      }
#pragma unroll
      for (int s2 = 0; s2 < 2; ++s2) { u32x4 t = {pkw[1][s2][0], pkw[1][s2][1], pkw[1][s2][2], pkw[1][s2][3]}; pf1[s2] = __builtin_bit_cast(bf16x8, t); }
#pragma unroll
      for (int j = 0; j < 4; ++j) {
        const int s2 = j >> 1, d = j & 1;
        o[d] = __builtin_amdgcn_mfma_f32_32x32x16_bf16(vf[d][1][s2], pf1[s2], o[d], 0, 0, 0);
      }
      l += ls2.x + ls2.y;
    }
    asm volatile("s_waitcnt vmcnt(0)" ::: "memory");
    __syncthreads();
  }
  const float lt = l + __shfl_xor(l, 32);
  const float inv = 1.f / lt;
  unsigned short* yr = Yp + tokq * ZLD;
#pragma unroll
  for (int d = 0; d < 2; ++d)
#pragma unroll
    for (int g = 0; g < 4; ++g) {
      u32x2 ov;
      ov.x = pk2(o[d][4 * g] * inv, o[d][4 * g + 1] * inv);
      ov.y = pk2(o[d][4 * g + 2] * inv, o[d][4 * g + 3] * inv);
      *(u32x2*)(yr + d * 32 + 8 * g + 4 * H) = ov;
    }
}

#ifndef PIPE_MLA
#define PIPE_MLA false
#endif
#ifndef PIPE_MIXA
#define PIPE_MIXA false
#endif
DI void phase_attention(const Params& P, int layer, char* smem, unsigned xcc) {
  unsigned* ctr = (unsigned*)(P.ws + OFF_CTR) + layer * 8 * 16;
  volatile int* slot = (volatile int*)(smem + 65528);
  const int tid = ltid();
  for (int d = 0; d < 8; ++d) {
    const int h = (int)((xcc + d) & 7u);
    for (;;) {
      if (tid == 0) *slot = (int)atomicAdd(ctr + h * 16, 1u);
      __syncthreads();
      const int r = *slot;
      __syncthreads();
      if (r >= 512) break;
      const int qt = 127 - (r & 127);
      const int mixer = (r >> 8) & 1, b = (r >> 7) & 1;
      if (mixer) attn_item<96, false, PIPE_MLA>(P, layer, smem, b, h, qt);
      else attn_item<64, true, PIPE_MIXA>(P, layer, smem, b, h, qt);
    }
  }
}

DI float sigmoidf_(float v) { return __builtin_amdgcn_rcpf(1.f + __expf(-v)); }

DI void phase_merge(const Params& P, int layer, char* smem) {
  const bf16* hn = (const bf16*)(P.ws + OFF_HN);
  const bf16* Z = (const bf16*)(P.ws + OFF_Z);
  const bf16* wl = (const bf16*)(P.ws + OFF_WT) + layer * W_LAYER;
  unsigned short* MG = (unsigned short*)(P.ws + OFF_QB);
  unsigned short* TG = (unsigned short*)(P.ws + OFF_VTA);
  const float* bg = P.b_gate + layer * 2048;
  for (int t0 = blockIdx.x; t0 < 256 * 8; t0 += gridDim.x) {
    const int t = xcd_tile(t0, 256 * 8);
    const int m0 = (t >> 3) * 128, n0 = (t & 7) * 128;
#pragma unroll 1
    for (int step = 0; step < 4; ++step) {
      f32x16 acc[2][2];
      const bool gate = step < 2;
      const bf16* A = gate ? hn : (Z + (step == 2 ? C_VA : C_QI));
      const bf16* Bt = wl + (step == 0 ? WO_IN + (size_t)C_GA * 1024 : step == 1 ? WO_IN + (size_t)C_GB * 1024 : step == 2 ? WO_PA : WO_PB);
      gemm_tile(smem, gate ? 16 : 8, A, gate ? 1024 : ZLD, m0, Bt, gate ? 1024 : 512, n0, acc);
      if (gate) {
        unsigned short* dst = step == 0 ? MG : TG;
        const float* bgs = bg + (step == 0 ? 0 : 1024);
        unsigned short* Cs = (unsigned short*)smem;
        epi_foreach(acc, [&](int row, int col, float v) __attribute__((always_inline)) {
          Cs[row * 136 + col] = f2bf(sigmoidf_(v + bgs[n0 + col]));
        });
        __syncthreads();
        store_tile16(Cs, dst + (size_t)m0 * 1024 + n0, 1024);
        __syncthreads();
      } else {
        unsigned short* Cs = (unsigned short*)smem;
        epi_foreach(acc, [&](int row, int col, float v) __attribute__((always_inline)) { Cs[row * 136 + col] = f2bf(v); });
        __syncthreads();
        const int tid_ = ltid();
#pragma unroll 2
        for (int i = 0; i < 8; ++i) {
          const int idx = tid_ + 256 * i;
          const int row = idx >> 4, c8 = (idx & 15) * 8;
          u32x4* gp = (u32x4*)(MG + (size_t)(m0 + row) * 1024 + n0 + c8);
          const u32x4 mg = *gp;
          const u32x4 pj = *(const u32x4*)(Cs + row * 136 + c8);
          u32x4 ov;
          if (step == 2) {
#pragma unroll
            for (int e = 0; e < 4; ++e) ov[e] = pk2(bflo(mg[e]) * bflo(pj[e]), bfhi(mg[e]) * bfhi(pj[e]));
          } else {
            const u32x4 tg = *(const u32x4*)(TG + (size_t)(m0 + row) * 1024 + n0 + c8);
#pragma unroll
            for (int e = 0; e < 4; ++e) ov[e] = pk2(bflo(mg[e]) + bflo(tg[e]) * bflo(pj[e]), bfhi(mg[e]) + bfhi(tg[e]) * bfhi(pj[e]));
          }
          *gp = ov;
        }
        __syncthreads();
      }
    }
  }
}

DI void phase_out(const Params& P, int layer, const float* xin, char* smem) {
  const bf16* MG = (const bf16*)(P.ws + OFF_QB);
  const bf16* wl = (const bf16*)(P.ws + OFF_WT) + layer * W_LAYER;
  const int lane = ltid() & 63, w = ltid() >> 6;
  const int wm = w >> 1, wn = w & 1;
  for (int t0 = blockIdx.x; t0 < 256 * 8; t0 += gridDim.x) {
    const int t = xcd_tile(t0, 256 * 8);
    const int m0 = (t >> 3) * 128, n0 = (t & 7) * 128;
    f32x16 acc[2][2];
    float xr[2][2][16];
    const unsigned obase_b = 4u * (unsigned)((m0 + wm * 64 + 4 * (lane >> 5)) * 1024 + n0 + wn * 64 + (lane & 31));
#pragma unroll
    for (int mb = 0; mb < 2; ++mb)
#pragma unroll
      for (int nb = 0; nb < 2; ++nb)
#pragma unroll
        for (int r = 0; r < 16; ++r) xr[mb][nb][r] = (*uoff(xin + ((mb * 32 + (r & 3) + 8 * (r >> 2)) * 1024 + nb * 32), obase_b));
    gemm_tile(smem, 16, MG, 1024, m0, wl + WO_OUT, 1024, n0, acc);
#pragma unroll
    for (int mb = 0; mb < 2; ++mb)
#pragma unroll
      for (int nb = 0; nb < 2; ++nb)
#pragma unroll
        for (int r = 0; r < 16; ++r)
          (*uoff(P.out + ((mb * 32 + (r & 3) + 8 * (r >> 2)) * 1024 + nb * 32), obase_b)) = xr[mb][nb][r] + acc[mb][nb][r];
  }
}

DI void phase_up(const Params& P, int layer, char* smem) {
  const bf16* hn = (const bf16*)(P.ws + OFF_HN);
  const bf16* wup = (const bf16*)(P.ws + OFF_WT) + layer * W_LAYER + WO_UP;
  unsigned short* ACT = (unsigned short*)(P.ws + OFF_Z);
  const float* cw = P.conv_w + (size_t)layer * 3 * 5632;
  const float* cb = P.conv_b + (size_t)layer * 5632;
  unsigned short* Cs = (unsigned short*)smem;
  const int tid = ltid();
  constexpr int MT = 262, NT = 44;
  for (int t0 = blockIdx.x; t0 < MT * NT; t0 += gridDim.x) {
    const int tl = xcd_tile(t0, MT * NT) - (t0 & 7) * ((MT * NT) >> 3);
    const int mt = (t0 & 1) * 131 + tl / 11, nt = ((t0 & 7) >> 1) * 11 + tl % 11;
    const int b = mt / 131, i = mt % 131;
    const int tb0 = i * 126 - 2;
    unsigned aoff[4], boff[4];
    const char* Abase = (const char*)(hn + (size_t)b * S_ * 1024);
    const unsigned zoff = (unsigned)((P.ws + OFF_ZPAGE) - Abase);
#pragma unroll
    for (int q = 0; q < 4; ++q) {
      const int r = glds_row(q), ch = glds_chunk(r);
      const int tb = tb0 + r;
      const bool ok = (tb >= 0) && (tb < S_);
      aoff[q] = ok ? (unsigned)((tb * 1024 + ch * 8) * 2) : zoff;
      const int wr = (r < 64) ? (nt * 64 + r) : (DFF + nt * 64 + r - 64);
      boff[q] = (unsigned)((wr * 1024 + ch * 8) * 2);
    }
    f32x16 acc[2][2];
    gemm_core(smem, 16, Abase, (const char*)wup, aoff, boff, acc);
    epi_foreach(acc, [&](int row, int col, float v) __attribute__((always_inline)) { Cs[row * 136 + col] = f2bf(v); });
    __syncthreads();
    {
      const int col = tid & 63, rb = tid >> 6;
      const int cv = nt * 64 + col, cg_ = DFF + nt * 64 + col;
      const float w0v = cw[cv], w1v = cw[5632 + cv], w2v = cw[2 * 5632 + cv], bv = cb[cv];
      const float w0g = cw[cg_], w1g = cw[5632 + cg_], w2g = cw[2 * 5632 + cg_], bgt = cb[cg_];
      for (int r = 2 + rb; r < 128; r += 4) {
        const int tb = tb0 + r;
        if (tb < S_) {
          const float val = bv + w0v * bf2f(Cs[(r - 2) * 136 + col]) + w1v * bf2f(Cs[(r - 1) * 136 + col]) + w2v * bf2f(Cs[r * 136 + col]);
          const float gat = bgt + w0g * bf2f(Cs[(r - 2) * 136 + 64 + col]) + w1g * bf2f(Cs[(r - 1) * 136 + 64 + col]) + w2g * bf2f(Cs[r * 136 + 64 + col]);
          const float a = gat / (1.f + __expf(-gat)) * val;
          ACT[(size_t)(b * S_ + tb) * DFF + cv] = f2bf(a);
        }
      }
    }
    __syncthreads();
  }
}

DI void phase_down(const Params& P, int layer, char* smem) {
  const bf16* ACT = (const bf16*)(P.ws + OFF_Z);
  const bf16* wl = (const bf16*)(P.ws + OFF_WT) + layer * W_LAYER;
  const int lane = ltid() & 63, w = ltid() >> 6;
  const int wm = w >> 1, wn = w & 1;
  for (int t0 = blockIdx.x; t0 < 256 * 8; t0 += gridDim.x) {
    const int t = xcd_tile(t0, 256 * 8);
    const int m0 = (t >> 3) * 128, n0 = (t & 7) * 128;
    f32x16 acc[2][2];
    float xr[2][2][16];
    const float* xld = P.out; asm volatile("" : "+s"(xld));
    const unsigned obase_b = 4u * (unsigned)((m0 + wm * 64 + 4 * (lane >> 5)) * 1024 + n0 + wn * 64 + (lane & 31));
#pragma unroll
    for (int mb = 0; mb < 2; ++mb)
#pragma unroll
      for (int nb = 0; nb < 2; ++nb)
#pragma unroll
        for (int r = 0; r < 16; ++r) xr[mb][nb][r] = (*uoff(xld + ((mb * 32 + (r & 3) + 8 * (r >> 2)) * 1024 + nb * 32), obase_b));
    gemm_tile(smem, 44, ACT, DFF, m0, wl + WO_DOWN, DFF, n0, acc);
    float* xst = P.out; asm volatile("" : "+s"(xst));
#pragma unroll
    for (int mb = 0; mb < 2; ++mb)
#pragma unroll
      for (int nb = 0; nb < 2; ++nb)
#pragma unroll
        for (int r = 0; r < 16; ++r)
          (*uoff(xst + ((mb * 32 + (r & 3) + 8 * (r >> 2)) * 1024 + nb * 32), obase_b)) = xr[mb][nb][r] + acc[mb][nb][r];
  }
}

#define XB_TMO      128
#define XB_XCNT(j)  (256  + 64 * (j))
#define XB_XSUB(j)  (1280 + 64 * (j))
#define XB_XGEN(j)  (2304 + 64 * (j))
#define XB_TOP      3328
#define XB_TOPGEN   3392
#define XCD_BAR_WORDS 3456
#define XB_SPIN_CAP (1u << 22)
#define LAS __attribute__((address_space(3)))
DI unsigned xb_ld(unsigned* p)              { return __hip_atomic_load(p, __ATOMIC_RELAXED, __HIP_MEMORY_SCOPE_AGENT); }
DI unsigned xb_add(unsigned* p, unsigned v) { return __hip_atomic_fetch_add(p, v, __ATOMIC_RELAXED, __HIP_MEMORY_SCOPE_AGENT); }
DI unsigned xb_xcc_id() { return (unsigned)__builtin_amdgcn_s_getreg((3 << 11) | 20) & 0xFu; }
#define XB_SPIN(cond, bar) do { unsigned _sp = 0; while (cond) { __builtin_amdgcn_s_sleep(1); \
    if ((++_sp & 255u) == 0u) { if (xb_ld(&(bar)[XB_TMO])) break; if (_sp > XB_SPIN_CAP) { atomicAdd(&(bar)[XB_TMO], 1u); break; } } } } while (0)
struct XcdBarrier { unsigned* bar; unsigned x; unsigned nloc, nx; };
DI XcdBarrier xcd_barrier_post(unsigned* bar) {
  XcdBarrier b; b.bar = bar; b.x = xb_xcc_id(); b.nloc = 0u; b.nx = 0u;
  if (threadIdx.x == 0) (void)xb_add(&bar[XB_XCNT(b.x)], 1u);
  return b;
}
DI void xcd_barrier_complete(unsigned* bar, unsigned x, unsigned& nloc, unsigned& nx) {
  const unsigned G = gridDim.x * gridDim.y * gridDim.z;
  unsigned sum, cnt, mine, sp = 0u;
  for (;;) {
    sum = 0u; cnt = 0u; mine = 0u;
#pragma unroll
    for (unsigned j = 0; j < 16; ++j) { const unsigned c = xb_ld(&bar[XB_XCNT(j)]); sum += c; cnt += (c > 0u) ? 1u : 0u; mine = (j == x) ? c : mine; }
    if (sum == G) break;
    __builtin_amdgcn_s_sleep(1);
    if ((++sp & 255u) == 0u) { if (xb_ld(&bar[XB_TMO])) break; if (sp > XB_SPIN_CAP) { atomicAdd(&bar[XB_TMO], 1u); break; } }
  }
  nloc = mine > 0u ? mine : 1u; nx = cnt > 0u ? cnt : 1u;
}
DI void xcd_barrier(XcdBarrier& b) {
  asm volatile("s_waitcnt vmcnt(0)" ::: "memory");
  __syncthreads();
  if (threadIdx.x == 0) {
    unsigned* bar = b.bar;
    __builtin_amdgcn_s_waitcnt(0);
    unsigned nloc = b.nloc, nx = b.nx;
    if (nloc == 0u) { xcd_barrier_complete(bar, b.x, nloc, nx); b.nloc = nloc; b.nx = nx; }
    const unsigned old = xb_add(&bar[XB_XSUB(b.x)], 1u);
    const unsigned gen = old / nloc;
    if (old + 1u == (gen + 1u) * nloc) {
      __builtin_amdgcn_fence(__ATOMIC_RELEASE, "agent");
      asm volatile("s_waitcnt vmcnt(0)" ::: "memory");
      const unsigned og = xb_add(&bar[XB_TOP], 1u);
      const unsigned tg = og / nx;
      if (og + 1u == (tg + 1u) * nx) xb_add(&bar[XB_TOPGEN], 1u);
      else XB_SPIN(xb_ld(&bar[XB_TOPGEN]) == tg, bar);
      __builtin_amdgcn_fence(__ATOMIC_ACQUIRE, "agent");
      xb_add(&bar[XB_XGEN(b.x)], 1u);
      asm volatile("s_waitcnt vmcnt(0)" ::: "memory");
    } else {
      XB_SPIN(xb_ld(&bar[XB_XGEN(b.x)]) == gen, bar);
      __builtin_amdgcn_fence(__ATOMIC_ACQUIRE, "agent");
      asm volatile("s_waitcnt vmcnt(0)" ::: "memory");
    }
  }
  __syncthreads();
}

constexpr int PH_PER_LAYER = 11;
constexpr int NPHASES = 2 * PH_PER_LAYER;

DI void run_phase(const Params& P, int ph, char* smem, unsigned xcc) {
  const int layer = ph / PH_PER_LAYER, p = ph % PH_PER_LAYER;
  const float* xin = layer == 0 ? P.x : P.out;
  bf16* HN = (bf16*)(P.ws + OFF_HN);
  switch (p) {
    case 0:
      if (layer == 0) phase_convert(P, smem);
      phase_zero_mask(P);
      phase_rmsnorm(xin, P.norm_mix + layer * 1024, HN);
      break;
    case 1: phase_gemm_in(P, layer, smem); break;
    case 2: phase_token_a(P, layer, smem); break;
    case 3: phase_gemm_lat(P, layer, smem); break;
    case 4: phase_token_c(P, layer, smem); phase_indexer(P, smem); break;
    case 5: phase_attention(P, layer, smem, xcc); phase_rmsnorm(xin, P.norm_mix + layer * 1024, HN); break;
    case 6: phase_merge(P, layer, smem); break;
    case 7: phase_out(P, layer, xin, smem); break;
    case 8: phase_rmsnorm(P.out, P.norm_ffn + layer * 1024, HN); break;
    case 9: phase_up(P, layer, smem); break;
    case 10: phase_down(P, layer, smem); break;
  }
}

__global__ void __launch_bounds__(256, 2) mega_kernel(Params P, int ph_begin, int ph_end) {
  __shared__ __attribute__((aligned(1024))) char smem[65536];
  cg::grid_group grid = cg::this_grid();
  XcdBarrier xb = xcd_barrier_post((unsigned*)(P.ws + OFF_BAR));
  for (int ph = ph_begin; ph < ph_end; ++ph) {
    run_phase(P, ph, smem, xb.x);
    if (ph + 1 < ph_end) {
      if (ph_end > 1000) grid.sync();
      else xcd_barrier(xb);
    }
  }
}

extern "C" void kernel_launch(void* const* d_in, const int* in_sizes, int n_in, void* d_out, int out_size, void* d_ws,
                              size_t ws_size, hipStream_t stream) {
  Params P{};
  P.x = (const float*)d_in[0]; P.rel_bias = (const float*)d_in[1]; P.norm_mix = (const float*)d_in[2];
  P.w_in = (const float*)d_in[3]; P.a_q_norm = (const float*)d_in[4]; P.a_k_norm = (const float*)d_in[5];
  P.b_cq_norm = (const float*)d_in[6]; P.b_ckv_norm = (const float*)d_in[7]; P.b_w_uq = (const float*)d_in[8];
  P.b_w_ukv = (const float*)d_in[9]; P.b_q_norm = (const float*)d_in[10]; P.b_k_norm = (const float*)d_in[11];
  P.w_proj_a = (const float*)d_in[12]; P.w_proj_b = (const float*)d_in[13]; P.b_gate = (const float*)d_in[14];
  P.w_out = (const float*)d_in[15]; P.norm_ffn = (const float*)d_in[16]; P.w_up = (const float*)d_in[17];
  P.conv_w = (const float*)d_in[18]; P.conv_b = (const float*)d_in[19]; P.w_down = (const float*)d_in[20];
  P.out = (float*)d_out; P.ws = (char*)d_ws;
  static int grid_blocks = 0;
  if (!grid_blocks) {
    int dev = 0, cus = 0, per_cu = 0;
    hipGetDevice(&dev);
    hipDeviceGetAttribute(&cus, hipDeviceAttributeMultiprocessorCount, dev);
    hipOccupancyMaxActiveBlocksPerMultiprocessor(&per_cu, mega_kernel, 256, 0);
    if (per_cu > 2) per_cu = 2;
    if (per_cu < 1) per_cu = 1;
    grid_blocks = cus * per_cu;
  }
#if MULTI_LAUNCH
  for (int ph = 0; ph < NPHASES; ++ph) {
    hipLaunchKernelGGL(mega_kernel, dim3(grid_blocks), dim3(256), 0, stream, P, ph, ph + 1);
  }
#else
  hipMemsetAsync((char*)d_ws + OFF_BAR, 0, 65536, stream);
  int b = 0, e = NPHASES;
  void* args[] = {&P, &b, &e};
  hipError_t err = hipLaunchCooperativeKernel((void*)mega_kernel, dim3(grid_blocks), dim3(256), args, 0, stream);
  if (err != hipSuccess) fprintf(stderr, "cooperative launch failed: %s (grid %d)\n", hipGetErrorString(err), grid_blocks);
#endif
}
```

```cpp
#include <hip/hip_runtime.h>
#include <hip/hip_cooperative_groups.h>
#include <cstdio>
namespace cg = cooperative_groups;

#ifndef MULTI_LAUNCH
#define MULTI_LAUNCH 0
#endif

typedef __bf16 bf16;
using bf16x8 = __attribute__((ext_vector_type(8))) __bf16;
using bf16x2 = __attribute__((ext_vector_type(2))) __bf16;
using f16x8  = __attribute__((ext_vector_type(8))) _Float16;
using f32x16 = __attribute__((ext_vector_type(16))) float;
using f32x4  = __attribute__((ext_vector_type(4))) float;
using f32x2  = __attribute__((ext_vector_type(2))) float;
using u32x4  = __attribute__((ext_vector_type(4))) unsigned;
using u32x2  = __attribute__((ext_vector_type(2))) unsigned;
using u32x8  = __attribute__((ext_vector_type(8))) unsigned;
#define DI __device__ __forceinline__

constexpr int T_ = 32768, S_ = 16384, DM = 1024;
constexpr int ZLD = 2816;
constexpr int C_QA = 0, C_KA = 512, C_VA = 1024, C_QI = 1536, C_KI = 2048, C_WI = 2112, C_CQ = 2120, C_CKV = 2504, C_KR = 2760;
constexpr int INC = 4840, C_GA = 2792, C_GB = 3816;
constexpr int DFF = 2816;
constexpr float EPS = 1e-6f;
constexpr float LOG2E = 1.4426950408889634f;

constexpr size_t WO_IN = 0;
constexpr size_t WO_UQ = WO_IN + (size_t)INC * 1024;
constexpr size_t WO_UKV = WO_UQ + 768 * 384;
constexpr size_t WO_PA = WO_UKV + 1024 * 256;
constexpr size_t WO_PB = WO_PA + 1024 * 512;
constexpr size_t WO_OUT = WO_PB + 1024 * 512;
constexpr size_t WO_UP = WO_OUT + 1024 * 1024;
constexpr size_t WO_DOWN = WO_UP + (size_t)5632 * 1024;
constexpr size_t W_LAYER = WO_DOWN + (size_t)1024 * 2816;

constexpr size_t MiB = 1048576;
constexpr size_t OFF_WT = 0;
constexpr size_t OFF_HN = 63 * MiB;
constexpr size_t OFF_MASK = 127 * MiB;
constexpr size_t OFF_Z = 160 * MiB;
constexpr size_t OFF_QB = 336 * MiB;
constexpr size_t OFF_KB = 384 * MiB;
constexpr size_t OFF_VTA = 432 * MiB;
constexpr size_t OFF_VTB = 464 * MiB;
constexpr size_t OFF_BAR = 500 * MiB;
constexpr size_t OFF_CTR = 500 * MiB + 16384;
constexpr size_t OFF_ZPAGE = 500 * MiB + 32768;
constexpr size_t MASK_WORDS_B = 4210688;
constexpr size_t MASK_BYTES = MASK_WORDS_B * 2 * 4;

struct Params {
  const float* x; const float* rel_bias; const float* norm_mix; const float* w_in; const float* a_q_norm; const float* a_k_norm;
  const float* b_cq_norm; const float* b_ckv_norm; const float* b_w_uq; const float* b_w_ukv; const float* b_q_norm; const float* b_k_norm;
  const float* w_proj_a; const float* w_proj_b; const float* b_gate; const float* w_out; const float* norm_ffn; const float* w_up;
  const float* conv_w; const float* conv_b; const float* w_down;
  float* out; char* ws;
};

DI int ltid() { int t = threadIdx.x; asm volatile("" : "+v"(t)); return t; }
DI unsigned short f2bf(float f) { return __builtin_bit_cast(unsigned short, (__bf16)f); }
DI unsigned pk2(float a, float b) { f32x2 v = {a, b}; return __builtin_bit_cast(unsigned, __builtin_convertvector(v, bf16x2)); }
DI float bf2f(unsigned short u) { return __uint_as_float(((unsigned)u) << 16); }
DI float bflo(unsigned u) { return __uint_as_float(u << 16); }
DI float bfhi(unsigned u) { return __uint_as_float(u & 0xffff0000u); }
DI unsigned short f2h(float f) { return __builtin_bit_cast(unsigned short, (_Float16)f); }
DI float wave_sum(float v) {
#pragma unroll
  for (int o = 32; o >= 1; o >>= 1) v += __shfl_xor(v, o);
  return v;
}
template <class T> DI T* uoff(T* base, unsigned byteoff) { return (T*)((char*)base + byteoff); }
template <class T> DI const T* uoff(const T* base, unsigned byteoff) { return (const T*)((const char*)base + byteoff); }
DI int xcd_tile(int t, int total) {
  const int local = t >> 3, l = local & 63;
  const int nl = (local & ~63) | (((l & 31) << 1) | (l >> 5));
  const int chunk = total >> 3;
  return (t & 7) * chunk + (((local | 63) < chunk) ? nl : local);
}
DI int mask_base(int b, int c) { return b * (int)MASK_WORDS_B + c * (c + 1) * 64; }

constexpr int STAGE_B = 32768;
#define WAIT_V0() asm volatile("s_waitcnt vmcnt(0)" ::: "memory")
DI void gemm_core(char* smem, int nk, const char* Ab, const char* Bb, const unsigned (&aoff)[4], const unsigned (&boff)[4],
                  f32x16 (&acc)[2][2]) {
  const int tid = ltid(), lane = tid & 63, w = tid >> 6;
  const int wm = w >> 1, wn = w & 1;
#pragma unroll
  for (int mb = 0; mb < 2; ++mb)
#pragma unroll
    for (int nb = 0; nb < 2; ++nb)
#pragma unroll
      for (int i = 0; i < 16; ++i) acc[mb][nb][i] = 0.f;
  const int l31 = lane & 31, H = lane >> 5, x = (l31 >> 1) & 7;
  const int a_base = (wm * 64 + l31) * 128, b_base = 16384 + (wn * 64 + l31) * 128;
  int xo[4];
#pragma unroll
  for (int ks = 0; ks < 4; ++ks) xo[ks] = ((2 * ks + H) ^ x) << 4;
  auto stage = [&](int buf, int kt) __attribute__((always_inline)) {
    const char* ak = Ab + kt * 128;
    const char* bk = Bb + kt * 128;
    char* sa = smem + buf * STAGE_B + w * 4096;
#pragma unroll
    for (int i = 0; i < 4; ++i) {
      __builtin_amdgcn_global_load_lds((const unsigned*)(ak + aoff[i]), (unsigned*)(sa + i * 1024), 16, 0, 0);
      __builtin_amdgcn_global_load_lds((const unsigned*)(bk + boff[i]), (unsigned*)(sa + 16384 + i * 1024), 16, 0, 0);
    }
  };
  stage(0, 0);
  WAIT_V0();
  __syncthreads();
  for (int kt = 0; kt < nk; ++kt) {
    const int cur = kt & 1;
    if (kt + 1 < nk) stage(cur ^ 1, kt + 1);
    const char* sb = smem + cur * STAGE_B;
#pragma unroll
    for (int ks = 0; ks < 4; ++ks) {
      bf16x8 af[2], bfr[2];
#pragma unroll
      for (int mb = 0; mb < 2; ++mb) af[mb] = *(const bf16x8*)(sb + a_base + mb * 4096 + xo[ks]);
#pragma unroll
      for (int nb = 0; nb < 2; ++nb) bfr[nb] = *(const bf16x8*)(sb + b_base + nb * 4096 + xo[ks]);
#pragma unroll
      for (int mb = 0; mb < 2; ++mb)
#pragma unroll
        for (int nb = 0; nb < 2; ++nb)
          acc[mb][nb] = __builtin_amdgcn_mfma_f32_32x32x16_bf16(af[mb], bfr[nb], acc[mb][nb], 0, 0, 0);
    }
    WAIT_V0();
    __syncthreads();
  }
}

DI int glds_row(int i) { const int tid = ltid(); return ((tid >> 6) * 4 + i) * 8 + ((tid & 63) >> 3); }
DI int glds_chunk(int row) { return (ltid() & 7) ^ ((row >> 1) & 7); }

template <class F>
DI void epi_foreach(const f32x16 (&acc)[2][2], F f) {
  const int lane = ltid() & 63, w = ltid() >> 6;
  const int wm = w >> 1, wn = w & 1;
#pragma unroll
  for (int mb = 0; mb < 2; ++mb)
#pragma unroll
    for (int nb = 0; nb < 2; ++nb)
#pragma unroll
      for (int r = 0; r < 16; ++r) {
        const int row = wm * 64 + mb * 32 + (r & 3) + 8 * (r >> 2) + 4 * (lane >> 5);
        const int col = wn * 64 + nb * 32 + (lane & 31);
        f(row, col, acc[mb][nb][r]);
        if ((r & 7) == 7) __builtin_amdgcn_sched_barrier(0);
      }
}

DI void store_tile16(const unsigned short* Cs, unsigned short* dst, int ldd) {
  const int tid = ltid();
#pragma unroll
  for (int i = 0; i < 8; ++i) {
    const int idx = tid + 256 * i;
    const int row = idx >> 4, c8 = (idx & 15) * 8;
    *(u32x4*)(dst + (size_t)row * ldd + c8) = *(const u32x4*)(Cs + row * 136 + c8);
  }
}

DI void gemm_tile(char* smem, int nk, const bf16* A, int lda, int m0, const bf16* Bt, int ldb, int n0, f32x16 (&acc)[2][2]) {
  unsigned aoff[4], boff[4];
#pragma unroll
  for (int i = 0; i < 4; ++i) {
    const int row = glds_row(i), ch = glds_chunk(row);
    aoff[i] = (unsigned)((row * lda + ch * 8) * 2);
    boff[i] = (unsigned)((row * ldb + ch * 8) * 2);
  }
  gemm_core(smem, nk, (const char*)(A + (size_t)m0 * lda), (const char*)(Bt + (size_t)n0 * ldb), aoff, boff, acc);
}

DI void transpose_tile(const float* src, bf16* dst, int K, int N, int t, char* smem) {
  unsigned short* ts = (unsigned short*)smem;
  const int tid = ltid();
  const int ntn = (N + 63) >> 6;
  const int n0 = (t % ntn) * 64, k0 = (t / ntn) * 64;
  {
    const int n4 = (tid & 15) * 4, kb = tid >> 4;
#pragma unroll
    for (int i = 0; i < 4; ++i) {
      const int k = kb + 16 * i;
      float4 v = {0.f, 0.f, 0.f, 0.f};
      if (n0 + n4 < N) v = *(const float4*)(src + (size_t)(k0 + k) * N + n0 + n4);
      ts[(n4 + 0) * 66 + k] = f2bf(v.x); ts[(n4 + 1) * 66 + k] = f2bf(v.y);
      ts[(n4 + 2) * 66 + k] = f2bf(v.z); ts[(n4 + 3) * 66 + k] = f2bf(v.w);
    }
  }
  __syncthreads();
  {
    const int n = tid >> 2, kc = tid & 3;
    if (n0 + n < N) {
      const unsigned* rp = (const unsigned*)(ts + n * 66 + kc * 16);
      u32x4 a = {rp[0], rp[1], rp[2], rp[3]}, b = {rp[4], rp[5], rp[6], rp[7]};
      u32x4* dp = (u32x4*)(dst + (size_t)(n0 + n) * K + k0 + kc * 16);
      dp[0] = a; dp[1] = b;
    }
  }
  __syncthreads();
}

DI void phase_convert(const Params& P, char* smem) {
  bf16* wt = (bf16*)(P.ws + OFF_WT);
  constexpr int NW = 8;
  const int Ks[NW] = {1024, 384, 256, 512, 512, 1024, 1024, 2816};
  const int Ns[NW] = {INC, 768, 1024, 1024, 1024, 1024, 5632, 1024};
  int total = 0;
#pragma unroll
  for (int i = 0; i < NW; ++i) total += ((Ns[i] + 63) >> 6) * (Ks[i] >> 6);
  for (int t = blockIdx.x; t < 2 * total; t += gridDim.x) {
    const int l = t >= total ? 1 : 0;
    int r = t - l * total;
    bf16* wl = wt + l * W_LAYER;
    const float* src = nullptr; bf16* dst = nullptr; int K = 64, N = 64;
    bool found = false;
#pragma unroll
    for (int i = 0; i < NW; ++i) {
      const int nt = ((Ns[i] + 63) >> 6) * (Ks[i] >> 6);
      if (!found && r < nt) {
        found = true; K = Ks[i]; N = Ns[i];
        const size_t lo = (size_t)l * Ks[i] * Ns[i];
        src = (i == 0 ? P.w_in : i == 1 ? P.b_w_uq : i == 2 ? P.b_w_ukv : i == 3 ? P.w_proj_a : i == 4 ? P.w_proj_b : i == 5 ? P.w_out : i == 6 ? P.w_up : P.w_down) + lo;
        dst = wl + (i == 0 ? WO_IN : i == 1 ? WO_UQ : i == 2 ? WO_UKV : i == 3 ? WO_PA : i == 4 ? WO_PB : i == 5 ? WO_OUT : i == 6 ? WO_UP : WO_DOWN);
      }
      if (!found) r -= nt;
    }
    transpose_tile(src, dst, K, N, r, smem);
  }
}

DI void phase_rmsnorm(const float* x, const float* g, bf16* hn) {
  const int lane = ltid() & 63, w = ltid() >> 6;
  for (int t = blockIdx.x * 4 + w; t < T_; t += gridDim.x * 4) {
    const float4* xr = (const float4*)(x + (size_t)t * DM);
    float4 v[4];
    float ss = 0.f;
#pragma unroll
    for (int i = 0; i < 4; ++i) {
      v[i] = xr[lane + 64 * i];
      ss += v[i].x * v[i].x + v[i].y * v[i].y + v[i].z * v[i].z + v[i].w * v[i].w;
    }
    ss = wave_sum(ss);
    const float r = rsqrtf(ss * (1.f / DM) + EPS);
#pragma unroll
    for (int i = 0; i < 4; ++i) {
      const float4 gg = ((const float4*)g)[lane + 64 * i];
      u32x2 o;
      o.x = pk2(v[i].x * r * gg.x, v[i].y * r * gg.y);
      o.y = pk2(v[i].z * r * gg.z, v[i].w * r * gg.w);
      *(u32x2*)(hn + (size_t)t * DM + (lane + 64 * i) * 4) = o;
    }
  }
}

DI void phase_zero_mask(const Params& P) {
  u32x4* m = (u32x4*)(P.ws + OFF_MASK);
  const size_t n = MASK_BYTES / 16;
  const u32x4 z = {0u, 0u, 0u, 0u};
  for (size_t i = (size_t)blockIdx.x * 256 + ltid(); i < n; i += (size_t)gridDim.x * 256) m[i] = z;
}

DI void phase_gemm_in(const Params& P, int layer, char* smem) {
  const bf16* hn = (const bf16*)(P.ws + OFF_HN);
  const bf16* wt = (const bf16*)(P.ws + OFF_WT) + layer * W_LAYER + WO_IN;
  unsigned short* Z = (unsigned short*)(P.ws + OFF_Z);
  constexpr int NT = 22, MT = 256;
  for (int t0 = blockIdx.x; t0 < NT * MT; t0 += gridDim.x) {
    const int tl = xcd_tile(t0, NT * MT) - (t0 & 7) * ((NT * MT) >> 3);
    const int m0 = ((t0 & 3) * 64 + tl / 11) * 128, n0 = (((t0 & 7) >> 2) * 11 + tl % 11) * 128;
    f32x16 acc[2][2];
    gemm_tile(smem, 16, hn, 1024, m0, wt, 1024, n0, acc);
    unsigned short* Cs = (unsigned short*)smem;
    epi_foreach(acc, [&](int row, int col, float v) __attribute__((always_inline)) {
      const int c = n0 + col;
      Cs[row * 136 + col] = (c >= C_QI && c < C_CQ) ? f2h(v) : f2bf(v);
    });
    __syncthreads();
    store_tile16(Cs, Z + (size_t)m0 * ZLD + n0, ZLD);
    __syncthreads();
  }
}

DI void transpose_v(const unsigned short* src, int ld, int col0, int hs, unsigned short* dst, char* smem) {
  unsigned short* ts = (unsigned short*)smem;
  const int tid = ltid();
  const int nitems = (T_ / 64) * 8;
  for (int it = blockIdx.x; it < nitems; it += gridDim.x) {
    const int h = it & 7, tg = it >> 3;
    const int t0 = tg * 64;
#pragma unroll
    for (int i = 0; i < 2; ++i) {
      const int r = (tid >> 3) + 32 * i, ch = tid & 7;
      u32x4 v = *(const u32x4*)(src + (size_t)(t0 + r) * ld + col0 + h * hs + ch * 8);
      *(u32x4*)(ts + r * 72 + ch * 8) = v;
    }
    __syncthreads();
    const int b = t0 / S_, s0 = t0 % S_;
#pragma unroll
    for (int i = 0; i < 2; ++i) {
      const int dv = (tid >> 3) + 32 * i, c = tid & 7;
      unsigned short e[8];
#pragma unroll
      for (int j = 0; j < 8; ++j) e[j] = ts[(8 * c + j) * 72 + dv];
      u32x4 o;
      o.x = e[0] | ((unsigned)e[1] << 16); o.y = e[2] | ((unsigned)e[3] << 16);
      o.z = e[4] | ((unsigned)e[5] << 16); o.w = e[6] | ((unsigned)e[7] << 16);
      *(u32x4*)(dst + ((size_t)((b * 8 + h) * 64 + dv)) * S_ + s0 + 8 * c) = o;
    }
    __syncthreads();
  }
}

DI void phase_token_a(const Params& P, int layer, char* smem) {
  unsigned short* Z = (unsigned short*)(P.ws + OFF_Z);
  const int lane = ltid() & 63, w = ltid() >> 6;
  const float* gq = P.a_q_norm + layer * 64;
  const float* gk = P.a_k_norm + layer * 64;
  const float* gcq = P.b_cq_norm + layer * 384;
  const float* gckv = P.b_ckv_norm + layer * 256;
  for (int t = blockIdx.x * 4 + w; t < T_; t += gridDim.x * 4) {
    unsigned short* zr = Z + (size_t)t * ZLD;
#pragma unroll
    for (int which = 0; which < 2; ++which) {
      const float* g = which ? gk : gq;
      u32x4* p = (u32x4*)(zr + (which ? C_KA : C_QA) + lane * 8);
      u32x4 u = *p;
      float f[8] = {bflo(u.x), bfhi(u.x), bflo(u.y), bfhi(u.y), bflo(u.z), bfhi(u.z), bflo(u.w), bfhi(u.w)};
      float ss = 0.f;
#pragma unroll
      for (int j = 0; j < 8; ++j) ss += f[j] * f[j];
      ss += __shfl_xor(ss, 1); ss += __shfl_xor(ss, 2); ss += __shfl_xor(ss, 4);
      const float r = rsqrtf(ss * (1.f / 64) + EPS);
      const int c0 = (lane & 7) * 8;
#pragma unroll
      for (int j = 0; j < 8; ++j) f[j] = f[j] * r * g[c0 + j];
      u.x = pk2(f[0], f[1]); u.y = pk2(f[2], f[3]); u.z = pk2(f[4], f[5]); u.w = pk2(f[6], f[7]);
      *p = u;
    }
    {
      unsigned* p = (unsigned*)(zr + C_CQ + lane * 6);
      unsigned u0 = p[0], u1 = p[1], u2 = p[2];
      float f[6] = {bflo(u0), bfhi(u0), bflo(u1), bfhi(u1), bflo(u2), bfhi(u2)};
      float ss = 0.f;
#pragma unroll
      for (int j = 0; j < 6; ++j) ss += f[j] * f[j];
      ss = wave_sum(ss);
      const float r = rsqrtf(ss * (1.f / 384) + EPS);
#pragma unroll
      for (int j = 0; j < 6; ++j) f[j] = f[j] * r * gcq[lane * 6 + j];
      p[0] = pk2(f[0], f[1]); p[1] = pk2(f[2], f[3]); p[2] = pk2(f[4], f[5]);
    }
    {
      u32x2* p = (u32x2*)(zr + C_CKV + lane * 4);
      u32x2 u = *p;
      float f[4] = {bflo(u.x), bfhi(u.x), bflo(u.y), bfhi(u.y)};
      float ss = f[0] * f[0] + f[1] * f[1] + f[2] * f[2] + f[3] * f[3];
      ss = wave_sum(ss);
      const float r = rsqrtf(ss * (1.f / 256) + EPS);
#pragma unroll
      for (int j = 0; j < 4; ++j) f[j] = f[j] * r * gckv[lane * 4 + j];
      u.x = pk2(f[0], f[1]); u.y = pk2(f[2], f[3]);
      *p = u;
    }
    {
      const int i = lane & 15;
      const float x1 = bf2f(zr[C_KR + i]), x2 = bf2f(zr[C_KR + 16 + i]);
      const float inv = powf(10000.f, -(float)i / 16.f);
      const float ang = (float)(t % S_) * inv;
      float sn, cs;
      sincosf(ang, &sn, &cs);
      const float o1 = x1 * cs - x2 * sn, o2 = x1 * sn + x2 * cs;
      if (lane < 16) { zr[C_KR + i] = f2bf(o1); zr[C_KR + 16 + i] = f2bf(o2); }
    }
  }
  __syncthreads();
  transpose_v(Z, ZLD, C_VA, 64, (unsigned short*)(P.ws + OFF_VTA), smem);
}

DI void phase_gemm_lat(const Params& P, int layer, char* smem) {
  const bf16* Z = (const bf16*)(P.ws + OFF_Z);
  const bf16* wl = (const bf16*)(P.ws + OFF_WT) + layer * W_LAYER;
  unsigned short* QB = (unsigned short*)(P.ws + OFF_QB);
  unsigned short* KV = (unsigned short*)(P.ws + OFF_HN);
  constexpr int MT = 256;
  for (int t0 = blockIdx.x; t0 < MT * 14; t0 += gridDim.x) {
    const int t = xcd_tile(t0, MT * 14);
    const int mt = t / 14, nt = t % 14;
    const int m0 = mt * 128;
    const bool isq = nt < 6;
    const int n0 = (isq ? nt : nt - 6) * 128;
    f32x16 acc[2][2];
    gemm_tile(smem, isq ? 6 : 4, Z + (isq ? C_CQ : C_CKV), ZLD, m0, wl + (isq ? WO_UQ : WO_UKV), isq ? 384 : 256, n0, acc);
    unsigned short* dst = isq ? QB : KV;
    const int ldd = isq ? 768 : 1024;
    unsigned short* Cs = (unsigned short*)smem;
    epi_foreach(acc, [&](int row, int col, float v) __attribute__((always_inline)) { Cs[row * 136 + col] = f2bf(v); });
    __syncthreads();
    store_tile16(Cs, dst + (size_t)m0 * ldd + n0, ldd);
    __syncthreads();
  }
}

DI void phase_token_c(const Params& P, int layer, char* smem) {
  const unsigned short* Z = (const unsigned short*)(P.ws + OFF_Z);
  unsigned short* QB = (unsigned short*)(P.ws + OFF_QB);
  unsigned short* KB = (unsigned short*)(P.ws + OFF_KB);
  const unsigned short* KV = (const unsigned short*)(P.ws + OFF_HN);
  const int lane = ltid() & 63, w = ltid() >> 6;
  float* rowbuf = (float*)smem + w * 800;
  const float* gq = P.b_q_norm + layer * 96;
  const float* gk = P.b_k_norm + layer * 96;
  const int ngroups = T_ / 4;
  for (int gi = blockIdx.x; gi < ngroups; gi += gridDim.x) {
    const int t = gi * 4 + w;
    unsigned short* qr = QB + (size_t)t * 768;
#pragma unroll
    for (int i = 0; i < 3; ++i) {
      const u32x2 u = *(const u32x2*)(qr + (lane + 64 * i) * 4);
      float4 f = {bflo(u.x), bfhi(u.x), bflo(u.y), bfhi(u.y)};
      *(float4*)(rowbuf + (lane + 64 * i) * 4) = f;
    }
    if (lane < 16) {
      const float inv = powf(10000.f, -(float)lane / 16.f);
      const float ang = (float)(t % S_) * inv;
      float sn, cs;
      sincosf(ang, &sn, &cs);
      rowbuf[768 + lane] = cs; rowbuf[784 + lane] = sn;
    }
    __syncthreads();
    {
      float f[12];
      float ss = 0.f;
      const int hd = lane >> 3, j0 = (lane & 7) * 12;
#pragma unroll
      for (int e = 0; e < 12; ++e) {
        const int j = j0 + e;
        float v;
        if (j < 64) v = rowbuf[hd * 96 + j];
        else {
          const int i = (j - 64) & 15;
          const float x1 = rowbuf[hd * 96 + 64 + i], x2 = rowbuf[hd * 96 + 80 + i];
          const float cs = rowbuf[768 + i], sn = rowbuf[784 + i];
          v = (j < 80) ? (x1 * cs - x2 * sn) : (x1 * sn + x2 * cs);
        }
        f[e] = v; ss += v * v;
      }
      ss += __shfl_xor(ss, 1); ss += __shfl_xor(ss, 2); ss += __shfl_xor(ss, 4);
      const float r = rsqrtf(ss * (1.f / 96) + EPS);
      unsigned o[6];
#pragma unroll
      for (int e = 0; e < 6; ++e) o[e] = pk2(f[2 * e] * r * gq[j0 + 2 * e], f[2 * e + 1] * r * gq[j0 + 2 * e + 1]);
      u32x2* op = (u32x2*)(qr + lane * 12);
      op[0] = u32x2{o[0], o[1]}; op[1] = u32x2{o[2], o[3]}; op[2] = u32x2{o[4], o[5]};
    }
    {
      float f[12];
      float ss = 0.f;
      const int hd = lane >> 3, j0 = (lane & 7) * 12;
#pragma unroll
      for (int e = 0; e < 12; ++e) {
        const int j = j0 + e;
        const float v = (j < 64) ? bf2f(KV[(size_t)t * 1024 + hd * 128 + j]) : bf2f(Z[(size_t)t * ZLD + C_KR + (j - 64)]);
        f[e] = v; ss += v * v;
      }
      ss += __shfl_xor(ss, 1); ss += __shfl_xor(ss, 2); ss += __shfl_xor(ss, 4);
      const float r = rsqrtf(ss * (1.f / 96) + EPS);
      unsigned o[6];
#pragma unroll
      for (int e = 0; e < 6; ++e) o[e] = pk2(f[2 * e] * r * gk[j0 + 2 * e], f[2 * e + 1] * r * gk[j0 + 2 * e + 1]);
      u32x2* op = (u32x2*)(KB + ((size_t)((t / S_) * 8 + hd) * S_ + (t % S_)) * 96 + j0);
      op[0] = u32x2{o[0], o[1]}; op[1] = u32x2{o[2], o[3]}; op[2] = u32x2{o[4], o[5]};
    }
    __syncthreads();
  }
  __syncthreads();
  transpose_v(KV, 1024, 64, 128, (unsigned short*)(P.ws + OFF_VTB), smem);
}

DI unsigned f2o(float f) { unsigned u = __float_as_uint(f); return u ^ ((u >> 31) ? 0xffffffffu : 0x80000000u); }
DI float o2f(unsigned u) { return __uint_as_float(u ^ ((u >> 31) ? 0x80000000u : 0xffffffffu)); }

DI void topk_compact(float* sc, unsigned short* ix, int* cntp, float* taup, int lane) {
  const int n = *cntp;
  unsigned u[8]; unsigned id[8]; bool valid[8];
#pragma unroll
  for (int i = 0; i < 8; ++i) {
    const int p = lane + 64 * i;
    valid[i] = p < n;
    u[i] = valid[i] ? f2o(sc[p]) : 0u;
    id[i] = valid[i] ? (unsigned)ix[p] : 0xffffu;
  }
  unsigned prefix = 0; int kk = 256;
  for (int bit = 31; bit >= 0; --bit) {
    const unsigned cand = (prefix >> bit) | 1u;
    int c = 0;
#pragma unroll
    for (int i = 0; i < 8; ++i) c += __popcll(__ballot(valid[i] && ((u[i] >> bit) == cand)));
    if (c >= kk) prefix |= (1u << bit); else kk -= c;
  }
  int ceq = 0;
#pragma unroll
  for (int i = 0; i < 8; ++i) ceq += __popcll(__ballot(valid[i] && u[i] == prefix));
  unsigned idthr = 0xffffu;
  if (ceq != kk) {
    unsigned p2 = 0; int k2 = kk;
    for (int bit = 13; bit >= 0; --bit) {
      int c0 = 0;
#pragma unroll
      for (int i = 0; i < 8; ++i) c0 += __popcll(__ballot(valid[i] && u[i] == prefix && ((id[i] >> bit) == (p2 >> bit))));
      if (c0 < k2) { k2 -= c0; p2 |= (1u << bit); }
    }
    idthr = p2;
  }
  int base = 0;
  const unsigned long long lt = (1ull << lane) - 1ull;
#pragma unroll
  for (int i = 0; i < 8; ++i) {
    const bool keep = valid[i] && (u[i] > prefix || (u[i] == prefix && id[i] <= idthr));
    const unsigned long long m = __ballot(keep);
    if (keep) {
      const int pos = base + __popcll(m & lt);
      sc[pos] = o2f(u[i]); ix[pos] = (unsigned short)id[i];
    }
    base += __popcll(m);
  }
  if (lane == 0) { *cntp = base; *taup = o2f(prefix); }
}

constexpr int HB_LO = 124 * 16, HB_P = 192, HB_WORDS = 387;

template <int MODE>
DI void indexer_pass(const _Float16* kbase, int ntile_in, int ts, const f16x8 (&qf)[8][2], const f16x8 (&qc)[2], const float (&wq)[8], float* csc,
                     unsigned short* cix, int* cnt, float* tau, unsigned* hist, int* oflow, int lane, int w) {
  constexpr int NG = (MODE == 2) ? 2 : 4;
  const int ntile = (ntile_in + ts - 1) / ts;
  const int q = lane & 15, kg = lane >> 4;
  const int nstep = (ntile + NG - 1) / NG;
  f16x8 cur[NG][2], nxt[NG][2];
#pragma unroll
  for (int g = 0; g < NG; ++g) {
    int tl = g; tl = tl < ntile ? tl : ntile - 1;
    cur[g][0] = *(const f16x8*)(kbase + (size_t)(tl * ts) * 64 * ZLD);
    cur[g][1] = *(const f16x8*)(kbase + (size_t)(tl * ts) * 64 * ZLD + 32);
  }
  float tq = (MODE == 0) ? 0.f : tau[q];
  for (int st = 0; st < nstep; ++st) {
#pragma unroll
    for (int g = 0; g < NG; ++g) {
      int tl = NG * (st + 1) + g; tl = tl < ntile ? tl : ntile - 1;
      nxt[g][0] = *(const f16x8*)(kbase + (size_t)(tl * ts) * 64 * ZLD);
      nxt[g][1] = *(const f16x8*)(kbase + (size_t)(tl * ts) * 64 * ZLD + 32);
    }
    if (MODE == 2) tq = tau[q];
#pragma unroll
    for (int g = 0; g < NG; ++g) {
      const int tl = NG * st + g;
      if (tl < ntile) {
        f32x4 lin = {0.f, 0.f, 0.f, 0.f};
        lin = __builtin_amdgcn_mfma_f32_16x16x32_f16(cur[g][0], qc[0], lin, 0, 0, 0);
        lin = __builtin_amdgcn_mfma_f32_16x16x32_f16(cur[g][1], qc[1], lin, 0, 0, 0);
        float s[4] = {lin[0], lin[1], lin[2], lin[3]};
        f32x4 accp = {0.f, 0.f, 0.f, 0.f};
        accp = __builtin_amdgcn_mfma_f32_16x16x32_f16(cur[g][0], qf[0][0], accp, 0, 0, 0);
        accp = __builtin_amdgcn_mfma_f32_16x16x32_f16(cur[g][1], qf[0][1], accp, 0, 0, 0);
#pragma unroll
        for (int h = 0; h < 8; ++h) {
          f32x4 accn = {0.f, 0.f, 0.f, 0.f};
          if (h < 7) {
            accn = __builtin_amdgcn_mfma_f32_16x16x32_f16(cur[g][0], qf[h + 1][0], accn, 0, 0, 0);
            accn = __builtin_amdgcn_mfma_f32_16x16x32_f16(cur[g][1], qf[h + 1][1], accn, 0, 0, 0);
          }
          __builtin_amdgcn_sched_barrier(0);
#pragma unroll
          for (int r = 0; r < 4; ++r) {
            s[r] = fmaf(wq[h], __builtin_fabsf(accp[r]), s[r]);
            asm("" : "+v"(s[r]));
          }
          __builtin_amdgcn_sched_barrier(0);
          accp = accn;
        }
        if (MODE == 0) {
#pragma unroll
          for (int r = 0; r < 4; ++r) {
            const float score = s[r] + 0.f;
            const unsigned bits = __float_as_uint(score);
            int p = (int)((bits & 0x7fffffffu) >> 19) - (HB_LO - 1);
            p = p < 0 ? 0 : (p > HB_P ? HB_P : p);
            const int bin = (bits >> 31) ? (HB_P - p) : (HB_P + 1 + p);
            atomicAdd(hist + q * HB_WORDS + bin, 1u);
          }
        } else {
          float sc4[4]; bool ps[4]; int np = 0;
#pragma unroll
          for (int r = 0; r < 4; ++r) { sc4[r] = s[r] + 0.f; ps[r] = sc4[r] > tq; np += ps[r] ? 1 : 0; }
          if (__ballot(np > 0)) {
            int pos = q * 512 + atomicAdd(&cnt[q], np);
            const int lim = q * 512 + 512;
            if (MODE != 2) { if (__ballot(pos + np > lim)) { if (pos + np > lim) *oflow = 1; } }
            const int dummy = 16 * 512 + lane;
            const unsigned kbase16 = (unsigned)(tl * 64 + w * 16 + kg * 4);
#pragma unroll
            for (int r = 0; r < 4; ++r) {
              const bool ok = ps[r] && (MODE == 2 || pos < lim);
              const int idx = ok ? pos : dummy;
              csc[idx] = sc4[r];
              cix[idx] = (unsigned short)(kbase16 + r);
              pos += ps[r] ? 1 : 0;
            }
          }
        }
      }
    }
    if (MODE == 2) {
      __syncthreads();
#pragma unroll 1
      for (int jj = 0; jj < 4; ++jj) {
        const int qq = w * 4 + jj;
        if (cnt[qq] > 384) topk_compact(csc + qq * 512, cix + qq * 512, cnt + qq, tau + qq, lane);
      }
      __syncthreads();
    }
#pragma unroll
    for (int g = 0; g < NG; ++g) { cur[g][0] = nxt[g][0]; cur[g][1] = nxt[g][1]; }
  }
}

DI void phase_indexer(const Params& P, int layer, char* smem, unsigned xcc) {
  float* csc = (float*)(smem);
  unsigned short* cix = (unsigned short*)(smem + 34816);
  unsigned* hist = (unsigned*)(smem);
  int* cnt = (int*)(smem + 52224);
  float* tau = (float*)(cnt + 16);
  int* oflow = cnt + 32;
  const int tid = ltid(), lane = tid & 63, w = tid >> 6;
  const _Float16* Zh = (const _Float16*)(P.ws + OFF_Z);
  unsigned* mask = (unsigned*)(P.ws + OFF_MASK);
  unsigned* ctr = (unsigned*)(P.ws + OFF_CTR) + (2 + layer) * 8 * 16;
  volatile int* slot = (volatile int*)(smem + 65528);
  for (int dq = 0; dq < 8; ++dq)
  for (;;) {
    const int qx = (int)((xcc + dq) & 7u);
    __syncthreads();
    if (tid == 0) *slot = (int)atomicAdd(ctr + qx * 16, 1u);
    __syncthreads();
    const int r = *slot;
    if (r >= 256) break;
    const int c = 255 - r;
    const int b = qx >> 2, qsub = qx & 3;
    const int t0 = b * S_ + c * 64 + qsub * 16;
    if (c < 4) {
      if (tid < 2 * (c + 1) * 16) {
        const int kb = tid >> 4, ql = qsub * 16 + (tid & 15);
        mask[mask_base(b, c) + kb * 64 + ql] = 0xffffffffu;
      }
      continue;
    }
    const int q = lane & 15, kg = lane >> 4;
    f16x8 qf[8][2];
#pragma unroll
    for (int h = 0; h < 8; ++h)
#pragma unroll
      for (int ks = 0; ks < 2; ++ks)
        qf[h][ks] = *(const f16x8*)(Zh + (size_t)(t0 + q) * ZLD + C_QI + h * 64 + ks * 32 + kg * 8);
    float wq[8];
    {
      const f16x8 wv = *(const f16x8*)(Zh + (size_t)(t0 + q) * ZLD + C_WI);
#pragma unroll
      for (int h = 0; h < 8; ++h) wq[h] = (float)wv[h];
    }
    f16x8 qc[2];
#pragma unroll
    for (int ks = 0; ks < 2; ++ks)
#pragma unroll
      for (int jx = 0; jx < 8; ++jx) {
        float a = 0.f;
#pragma unroll
        for (int h = 0; h < 8; ++h) a = fmaf(wq[h], (float)qf[h][ks][jx], a);
        qc[ks][jx] = (_Float16)a;
      }
    const _Float16* kbase = Zh + (size_t)(b * S_ + w * 16 + q) * ZLD + C_KI + kg * 8;
    const int ntile = c + 1;
    for (int attempt = (ntile > 16) ? 0 : 1;; ++attempt) {
      __syncthreads();
      for (int i = tid; i < 16 * HB_WORDS; i += 256) hist[i] = 0u;
      if (tid < 16) { cnt[tid] = 0; tau[tid] = -INFINITY; }
      if (tid == 0) *oflow = 0;
      __syncthreads();
      if (attempt >= 2) {
        indexer_pass<2>(kbase, ntile, 1, qf, qc, wq, csc, cix, cnt, tau, hist, oflow, lane, w);
        break;
      }
      const int ts = attempt == 0 ? 2 : 1;
      indexer_pass<0>(kbase, ntile, ts, qf, qc, wq, csc, cix, cnt, tau, hist, oflow, lane, w);
      __syncthreads();
      if (tid < 16) {
        const int nsamp = (ntile + ts - 1) / ts;
        const int target = attempt == 0 ? (320 * nsamp + ntile - 1) / ntile : 256;
        const unsigned* hq = hist + tid * HB_WORDS;
        int cum = 0, B = 0;
        for (int bin = 2 * HB_P + 1; bin >= 0; --bin) {
          cum += (int)hq[bin];
          if (cum >= target) { B = bin; break; }
        }
        float t;
        if (B > HB_P) {
          const int p = B - HB_P - 1;
          t = (p == 0) ? -1e-30f : __uint_as_float((((unsigned)(p + HB_LO - 1)) << 19) - 1u);
        } else {
          const int p = HB_P - B;
          t = (p == HB_P) ? -INFINITY : -__uint_as_float(((unsigned)(p + HB_LO)) << 19);
        }
        tau[tid] = t;
      }
      __syncthreads();
      indexer_pass<1>(kbase, ntile, 1, qf, qc, wq, csc, cix, cnt, tau, hist, oflow, lane, w);
      __syncthreads();
      if (tid < 16 && cnt[tid] < 256) *oflow = 1;
      __syncthreads();
      if (!*oflow) break;
    }
#pragma unroll 1
    for (int jj = 0; jj < 4; ++jj) {
      const int qq = w * 4 + jj;
      if (cnt[qq] > 256) topk_compact(csc + qq * 512, cix + qq * 512, cnt + qq, tau + qq, lane);
      unsigned* mrow = mask + mask_base(b, c) + (qsub * 16 + qq);
#pragma unroll
      for (int i = 0; i < 4; ++i) {
        const unsigned key = cix[qq * 512 + lane + 64 * i];
        atomicOr(mrow + (key >> 5) * 64, 1u << (key & 31));
      }
    }
    __syncthreads();
  }
}

DI int t5_bucket(int rel) {
  const int n = rel < 0 ? -rel : rel;
  int bkt;
  if (n < 8) bkt = n; else if (n < 12) bkt = 8; else if (n < 16) bkt = 9; else if (n < 23) bkt = 10; else if (n < 32) bkt = 11;
  else if (n < 46) bkt = 12; else if (n < 64) bkt = 13; else if (n < 91) bkt = 14; else bkt = 15;
  return bkt + (rel > 0 ? 16 : 0);
}

template <int DQK, bool MIXA, bool PIPE>
DI void attn_item(const Params& P, int layer, char* smem, int b, int h, int qt) {
  constexpr int NS = DQK / 16;
  constexpr int KCH = DQK / 8;
  constexpr int KROWB = DQK * 2;
  constexpr int KTILE_B = 64 * KROWB;
  constexpr int STG_B = 20480;
  constexpr int NKI = KTILE_B / 4096;
  float* biasT = (float*)(smem + 2 * STG_B);
  const int tid = ltid(), lane = tid & 63, w = tid >> 6;
  const int H = lane >> 5, l31 = lane & 31;
  const unsigned short* Z = (const unsigned short*)(P.ws + OFF_Z);
  const unsigned short *Qp, *Kp, *VT;
  int ldq, ldk;
  unsigned short* Yp = (unsigned short*)(P.ws + OFF_Z);
  if (MIXA) {
    Qp = Z + C_QA + h * 64; Kp = Z + C_KA + h * 64 + (size_t)b * S_ * ZLD; ldq = ZLD; ldk = ZLD;
    VT = (const unsigned short*)(P.ws + OFF_VTA) + (size_t)((b * 8 + h) * 64) * S_;
    Yp += C_VA + h * 64;
  } else {
    Qp = (const unsigned short*)(P.ws + OFF_QB) + h * 96; ldq = 768;
    Kp = (const unsigned short*)(P.ws + OFF_KB) + (size_t)(b * 8 + h) * S_ * 96; ldk = 96;
    VT = (const unsigned short*)(P.ws + OFF_VTB) + (size_t)((b * 8 + h) * 64) * S_;
    Yp += C_QI + h * 64;
  }
  const unsigned* mask = (const unsigned*)(P.ws + OFF_MASK);
  const int tq0 = qt * 128 + w * 32;
  const int qpos = tq0 + l31;
  const int cw = tq0 >> 6;
  const size_t tokq = (size_t)b * S_ + qpos;
  const float sl2 = (MIXA ? 0.125f : 0.10206207261596575f) * LOG2E;
  float mfix;
  {
    const float* g1 = MIXA ? (P.a_q_norm + layer * 64) : (P.b_q_norm + layer * 96);
    const float* g2 = MIXA ? (P.a_k_norm + layer * 64) : (P.b_k_norm + layer * 96);
    float a1 = 0.f, a2 = 0.f;
    for (int i = 0; i < DQK; ++i) { a1 = fmaxf(a1, fabsf(g1[i])); a2 = fmaxf(a2, fabsf(g2[i])); }
    mfix = (float)DQK * 1.02f * a1 * a2 * sl2;
    if (MIXA) {
      const float b15 = P.rel_bias[15 * 8 + h];
      float bm = 0.f;
      for (int i = 0; i < 32; ++i) bm = fmaxf(bm, P.rel_bias[i * 8 + h] - b15);
      mfix += bm * LOG2E;
    }
  }
  if (MIXA) {
    const int rel = tid - 192;
    const float b15 = P.rel_bias[15 * 8 + h];
    biasT[tid] = (P.rel_bias[t5_bucket(rel) * 8 + h] - b15) * LOG2E;
  }
  bf16x8 qf[NS];
#pragma unroll
  for (int s = 0; s < NS; ++s) qf[s] = *(const bf16x8*)(Qp + tokq * ldq + 16 * s + 8 * H);
  const int nkt = 2 * qt + 2;
  unsigned koff[NKI], voff[2];
#pragma unroll
  for (int i = 0; i < NKI; ++i) {
    const int e = (w * NKI + i) * 64 + lane;
    const int row = e / KCH, slot = e % KCH;
    const int c = slot ^ (MIXA ? ((row >> 1) & 7) : ((row >> 2) & 3));
    koff[i] = (unsigned)((row * ldk + c * 8) * 2);
  }
#pragma unroll
  for (int i = 0; i < 2; ++i) {
    const int e = (w * 2 + i) * 64 + lane;
    const int row = e >> 3, slot = e & 7;
    const int c = slot ^ ((row >> 1) & 7);
    voff[i] = (unsigned)((row * S_ + c * 8) * 2);
  }
  unsigned mwn[2] = {0u, 0u};
  auto issue_loads = [&](int kt) __attribute__((always_inline)) {
    const char* kbp = (const char*)(Kp + (size_t)(kt * 64) * ldk);
    const char* vbp = (const char*)(VT + kt * 64);
    char* sk = smem + (kt & 1) * STG_B;
#pragma unroll
    for (int i = 0; i < NKI; ++i)
      __builtin_amdgcn_global_load_lds((const unsigned*)(kbp + koff[i]), (unsigned*)(sk + (w * NKI + i) * 1024), 16, 0, 0);
#pragma unroll
    for (int i = 0; i < 2; ++i)
      __builtin_amdgcn_global_load_lds((const unsigned*)(vbp + voff[i]), (unsigned*)(sk + KTILE_B + (w * 2 + i) * 1024), 16, 0, 0);
    if (MIXA) {
      if (kt <= cw) {
        const unsigned* mp = mask + mask_base(b, cw) + (2 * kt) * 64 + (qpos & 63);
        mwn[0] = mp[0]; mwn[1] = mp[64];
      }
    }
  };
  issue_loads(0);
  f32x16 o[2];
#pragma unroll
  for (int d = 0; d < 2; ++d)
#pragma unroll
    for (int i = 0; i < 16; ++i) o[d][i] = 0.f;
  float l = 0.f;
  const int pr = (l31 & ~12) | ((l31 & 4) << 1) | ((l31 & 8) >> 1);
  const int swk = MIXA ? ((pr >> 1) & 7) : ((pr >> 2) & 3), swv = (l31 >> 1) & 7;
  asm volatile("s_waitcnt vmcnt(0)" ::: "memory");
  __syncthreads();
  for (int kt = 0; kt < nkt; ++kt) {
    unsigned mw[2] = {mwn[0], mwn[1]};
    if (kt + 1 < nkt) issue_loads(kt + 1);
    const char* Ks = smem + (kt & 1) * STG_B;
    const char* Vs = Ks + KTILE_B;
    if (kt <= cw) {
      const int kc = kt;
      bf16x8 kf[2][NS];
#pragma unroll
      for (int kb = 0; kb < 2; ++kb)
#pragma unroll
        for (int s = 0; s < NS; ++s) kf[kb][s] = *(const bf16x8*)(Ks + (32 * kb + pr) * KROWB + (((2 * s + H) ^ swk) << 4));
      __builtin_amdgcn_sched_barrier(0);
      f32x16 sacc[2];
#pragma unroll
      for (int kb = 0; kb < 2; ++kb)
#pragma unroll
        for (int i = 0; i < 16; ++i) sacc[kb][i] = 0.f;
#pragma unroll
      for (int s = 0; s < NS; ++s) sacc[0] = __builtin_amdgcn_mfma_f32_32x32x16_bf16(kf[0][s], qf[s], sacc[0], 0, 0, 0);
      bf16x8 vf[2][2][2];
#pragma unroll
      for (int d = 0; d < 2; ++d)
#pragma unroll
        for (int kb = 0; kb < 2; ++kb)
#pragma unroll
          for (int s2 = 0; s2 < 2; ++s2)
            vf[d][kb][s2] = *(const bf16x8*)(Vs + (d * 32 + l31) * 128 + (((4 * kb + 2 * s2 + H) ^ swv) << 4));
      __builtin_amdgcn_sched_barrier(0);
      const bool near = MIXA && (kc >= cw - 2);
      f32x2 ls2 = {0.f, 0.f};
      const f32x2 sl2v = {sl2, sl2}, mfixv = {mfix, mfix};
      unsigned pkw[2][2][4];
      unsigned mrot[2];
#pragma unroll
      for (int kb = 0; kb < 2; ++kb) mrot[kb] = MIXA ? ((mw[kb] >> (8 * H)) << 8) : 0u;
      auto chunk = [&](int kb, int c) __attribute__((always_inline)) {
        const int s2 = 1 - (c >> 2), e = 3 - (c & 3);
        const int r0 = 8 * s2 + 2 * e;
        if (MIXA && c == 4) mrot[kb] <<= 8;
        f32x2 xv2 = {sacc[kb][r0], sacc[kb][r0 + 1]};
        xv2 = xv2 * sl2v - mfixv;
        if (MIXA) {
          if (near) {
            const int kl = 16 * (r0 >> 3) + 8 * H + (r0 & 7);
            const int rel = kc * 64 + 32 * kb + kl - qpos;
            xv2.x += biasT[rel + 192];
            xv2.y += biasT[rel + 193];
          }
        }
        f32x2 p2 = {__builtin_amdgcn_exp2f(xv2.x), __builtin_amdgcn_exp2f(xv2.y)};
        if (MIXA) {
          float px = p2.x, py = p2.y;
          asm volatile("v_add_co_u32 %0, vcc, %0, %0\n\tv_cndmask_b32 %1, 0, %1, vcc" : "+v"(mrot[kb]), "+v"(py) : : "vcc");
          asm volatile("v_add_co_u32 %0, vcc, %0, %0\n\tv_cndmask_b32 %1, 0, %1, vcc" : "+v"(mrot[kb]), "+v"(px) : : "vcc");
          p2.x = px; p2.y = py;
        }
        ls2 += p2;
        pkw[kb][s2][e] = pk2(p2.x, p2.y);
      };
      {
        int c0 = 0;
#pragma unroll
        for (int s = 0; s < NS; ++s) {
          sacc[1] = __builtin_amdgcn_mfma_f32_32x32x16_bf16(kf[1][s], qf[s], sacc[1], 0, 0, 0);
          const int cend = (8 * (s + 1)) / NS;
#pragma unroll
          for (int c = 0; c < 8; ++c) if (c >= c0 && c < cend) chunk(0, c);
          c0 = cend;
          __builtin_amdgcn_sched_barrier(0);
        }
      }
      bf16x8 pf0[2], pf1[2];
#pragma unroll
      for (int s2 = 0; s2 < 2; ++s2) { u32x4 t = {pkw[0][s2][0], pkw[0][s2][1], pkw[0][s2][2], pkw[0][s2][3]}; pf0[s2] = __builtin_bit_cast(bf16x8, t); }
#pragma unroll
      for (int j = 0; j < 4; ++j) {
        const int s2 = j >> 1, d = j & 1;
        o[d] = __builtin_amdgcn_mfma_f32_32x32x16_bf16(vf[d][0][s2], pf0[s2], o[d], 0, 0, 0);
        chunk(1, 2 * j); chunk(1, 2 * j + 1);
        __builtin_amdgcn_sched_barrier(0);
      }
#pragma unroll
      for (int s2 = 0; s2 < 2; ++s2) { u32x4 t = {pkw[1][s2][0], pkw[1][s2][1], pkw[1][s2][2], pkw[1][s2][3]}; pf1[s2] = __builtin_bit_cast(bf16x8, t); }
#pragma unroll
      for (int j = 0; j < 4; ++j) {
        const int s2 = j >> 1, d = j & 1;
        o[d] = __builtin_amdgcn_mfma_f32_32x32x16_bf16(vf[d][1][s2], pf1[s2], o[d], 0, 0, 0);
      }
      l += ls2.x + ls2.y;
    }
    asm volatile("s_waitcnt vmcnt(0)" ::: "memory");
    __syncthreads();
  }
  const float lt = l + __shfl_xor(l, 32);
  const float inv = 1.f / lt;
  unsigned short* yr = Yp + tokq * ZLD;
#pragma unroll
  for (int d = 0; d < 2; ++d)
#pragma unroll
    for (int g = 0; g < 4; ++g) {
      u32x2 ov;
      ov.x = pk2(o[d][4 * g] * inv, o[d][4 * g + 1] * inv);
      ov.y = pk2(o[d][4 * g + 2] * inv, o[d][4 * g + 3] * inv);
      *(u32x2*)(yr + d * 32 + 8 * g + 4 * H) = ov;
    }
}

#ifndef PIPE_MLA
#define PIPE_MLA false
#endif
#ifndef PIPE_MIXA
#define PIPE_MIXA false
#endif
DI void phase_attention(const Params& P, int layer, char* smem, unsigned xcc) {
  unsigned* ctr = (unsigned*)(P.ws + OFF_CTR) + layer * 8 * 16;
  volatile int* slot = (volatile int*)(smem + 65528);
  const int tid = ltid();
  for (int d = 0; d < 8; ++d) {
    const int h = (int)((xcc + d) & 7u);
    for (;;) {
      if (tid == 0) *slot = (int)atomicAdd(ctr + h * 16, 1u);
      __syncthreads();
      const int r = *slot;
      __syncthreads();
      if (r >= 512) break;
      const int qt = 127 - (r & 127);
      const int mixer = (r >> 8) & 1, b = (r >> 7) & 1;
      if (mixer) attn_item<96, false, PIPE_MLA>(P, layer, smem, b, h, qt);
      else attn_item<64, true, PIPE_MIXA>(P, layer, smem, b, h, qt);
    }
  }
}

DI float sigmoidf_(float v) { return __builtin_amdgcn_rcpf(1.f + __expf(-v)); }

DI void phase_merge(const Params& P, int layer, char* smem) {
  const bf16* hn = (const bf16*)(P.ws + OFF_HN);
  const bf16* Z = (const bf16*)(P.ws + OFF_Z);
  const bf16* wl = (const bf16*)(P.ws + OFF_WT) + layer * W_LAYER;
  unsigned short* MG = (unsigned short*)(P.ws + OFF_QB);
  unsigned short* TG = (unsigned short*)(P.ws + OFF_VTA);
  const float* bg = P.b_gate + layer * 2048;
  for (int t0 = blockIdx.x; t0 < 256 * 8; t0 += gridDim.x) {
    const int t = xcd_tile(t0, 256 * 8);
    const int m0 = (t >> 3) * 128, n0 = (t & 7) * 128;
#pragma unroll 1
    for (int step = 0; step < 4; ++step) {
      f32x16 acc[2][2];
      const bool gate = step < 2;
      const bf16* A = gate ? hn : (Z + (step == 2 ? C_VA : C_QI));
      const bf16* Bt = wl + (step == 0 ? WO_IN + (size_t)C_GA * 1024 : step == 1 ? WO_IN + (size_t)C_GB * 1024 : step == 2 ? WO_PA : WO_PB);
      gemm_tile(smem, gate ? 16 : 8, A, gate ? 1024 : ZLD, m0, Bt, gate ? 1024 : 512, n0, acc);
      if (gate) {
        unsigned short* dst = step == 0 ? MG : TG;
        const float* bgs = bg + (step == 0 ? 0 : 1024);
        unsigned short* Cs = (unsigned short*)smem;
        epi_foreach(acc, [&](int row, int col, float v) __attribute__((always_inline)) {
          Cs[row * 136 + col] = f2bf(sigmoidf_(v + bgs[n0 + col]));
        });
        __syncthreads();
        store_tile16(Cs, dst + (size_t)m0 * 1024 + n0, 1024);
        __syncthreads();
      } else {
        unsigned short* Cs = (unsigned short*)smem;
        epi_foreach(acc, [&](int row, int col, float v) __attribute__((always_inline)) { Cs[row * 136 + col] = f2bf(v); });
        __syncthreads();
        const int tid_ = ltid();
#pragma unroll 2
        for (int i = 0; i < 8; ++i) {
          const int idx = tid_ + 256 * i;
          const int row = idx >> 4, c8 = (idx & 15) * 8;
          u32x4* gp = (u32x4*)(MG + (size_t)(m0 + row) * 1024 + n0 + c8);
          const u32x4 mg = *gp;
          const u32x4 pj = *(const u32x4*)(Cs + row * 136 + c8);
          u32x4 ov;
          if (step == 2) {
#pragma unroll
            for (int e = 0; e < 4; ++e) ov[e] = pk2(bflo(mg[e]) * bflo(pj[e]), bfhi(mg[e]) * bfhi(pj[e]));
          } else {
            const u32x4 tg = *(const u32x4*)(TG + (size_t)(m0 + row) * 1024 + n0 + c8);
#pragma unroll
            for (int e = 0; e < 4; ++e) ov[e] = pk2(bflo(mg[e]) + bflo(tg[e]) * bflo(pj[e]), bfhi(mg[e]) + bfhi(tg[e]) * bfhi(pj[e]));
          }
          *gp = ov;
        }
        __syncthreads();
      }
    }
  }
}

DI void phase_out(const Params& P, int layer, const float* xin, char* smem) {
  const bf16* MG = (const bf16*)(P.ws + OFF_QB);
  const bf16* wl = (const bf16*)(P.ws + OFF_WT) + layer * W_LAYER;
  const int lane = ltid() & 63, w = ltid() >> 6;
  const int wm = w >> 1, wn = w & 1;
  for (int t0 = blockIdx.x; t0 < 256 * 8; t0 += gridDim.x) {
    const int t = xcd_tile(t0, 256 * 8);
    const int m0 = (t >> 3) * 128, n0 = (t & 7) * 128;
    f32x16 acc[2][2];
    float xr[2][2][16];
    const unsigned obase_b = 4u * (unsigned)((m0 + wm * 64 + 4 * (lane >> 5)) * 1024 + n0 + wn * 64 + (lane & 31));
#pragma unroll
    for (int mb = 0; mb < 2; ++mb)
#pragma unroll
      for (int nb = 0; nb < 2; ++nb)
#pragma unroll
        for (int r = 0; r < 16; ++r) xr[mb][nb][r] = (*uoff(xin + ((mb * 32 + (r & 3) + 8 * (r >> 2)) * 1024 + nb * 32), obase_b));
    gemm_tile(smem, 16, MG, 1024, m0, wl + WO_OUT, 1024, n0, acc);
#pragma unroll
    for (int mb = 0; mb < 2; ++mb)
#pragma unroll
      for (int nb = 0; nb < 2; ++nb)
#pragma unroll
        for (int r = 0; r < 16; ++r)
          (*uoff(P.out + ((mb * 32 + (r & 3) + 8 * (r >> 2)) * 1024 + nb * 32), obase_b)) = xr[mb][nb][r] + acc[mb][nb][r];
  }
}

DI void phase_up(const Params& P, int layer, char* smem) {
  const bf16* hn = (const bf16*)(P.ws + OFF_HN);
  const bf16* wup = (const bf16*)(P.ws + OFF_WT) + layer * W_LAYER + WO_UP;
  unsigned short* ACT = (unsigned short*)(P.ws + OFF_Z);
  const float* cw = P.conv_w + (size_t)layer * 3 * 5632;
  const float* cb = P.conv_b + (size_t)layer * 5632;
  unsigned short* Cs = (unsigned short*)smem;
  const int tid = ltid();
  constexpr int MT = 262, NT = 44;
  for (int t0 = blockIdx.x; t0 < MT * NT; t0 += gridDim.x) {
    const int tl = xcd_tile(t0, MT * NT) - (t0 & 7) * ((MT * NT) >> 3);
    const int mt = (t0 & 1) * 131 + tl / 11, nt = ((t0 & 7) >> 1) * 11 + tl % 11;
    const int b = mt / 131, i = mt % 131;
    const int tb0 = i * 126 - 2;
    unsigned aoff[4], boff[4];
    const char* Abase = (const char*)(hn + (size_t)b * S_ * 1024);
    const unsigned zoff = (unsigned)((P.ws + OFF_ZPAGE) - Abase);
#pragma unroll
    for (int q = 0; q < 4; ++q) {
      const int r = glds_row(q), ch = glds_chunk(r);
      const int tb = tb0 + r;
      const bool ok = (tb >= 0) && (tb < S_);
      aoff[q] = ok ? (unsigned)((tb * 1024 + ch * 8) * 2) : zoff;
      const int wr = (r < 64) ? (nt * 64 + r) : (DFF + nt * 64 + r - 64);
      boff[q] = (unsigned)((wr * 1024 + ch * 8) * 2);
    }
    f32x16 acc[2][2];
    gemm_core(smem, 16, Abase, (const char*)wup, aoff, boff, acc);
    epi_foreach(acc, [&](int row, int col, float v) __attribute__((always_inline)) { Cs[row * 136 + col] = f2bf(v); });
    __syncthreads();
    {
      const int col = tid & 63, rb = tid >> 6;
      const int cv = nt * 64 + col, cg_ = DFF + nt * 64 + col;
      const float w0v = cw[cv], w1v = cw[5632 + cv], w2v = cw[2 * 5632 + cv], bv = cb[cv];
      const float w0g = cw[cg_], w1g = cw[5632 + cg_], w2g = cw[2 * 5632 + cg_], bgt = cb[cg_];
      for (int r = 2 + rb; r < 128; r += 4) {
        const int tb = tb0 + r;
        if (tb < S_) {
          const float val = bv + w0v * bf2f(Cs[(r - 2) * 136 + col]) + w1v * bf2f(Cs[(r - 1) * 136 + col]) + w2v * bf2f(Cs[r * 136 + col]);
          const float gat = bgt + w0g * bf2f(Cs[(r - 2) * 136 + 64 + col]) + w1g * bf2f(Cs[(r - 1) * 136 + 64 + col]) + w2g * bf2f(Cs[r * 136 + 64 + col]);
          const float a = gat / (1.f + __expf(-gat)) * val;
          ACT[(size_t)(b * S_ + tb) * DFF + cv] = f2bf(a);
        }
      }
    }
    __syncthreads();
  }
}

DI void phase_down(const Params& P, int layer, char* smem) {
  const bf16* ACT = (const bf16*)(P.ws + OFF_Z);
  const bf16* wl = (const bf16*)(P.ws + OFF_WT) + layer * W_LAYER;
  const int lane = ltid() & 63, w = ltid() >> 6;
  const int wm = w >> 1, wn = w & 1;
  for (int t0 = blockIdx.x; t0 < 256 * 8; t0 += gridDim.x) {
    const int t = xcd_tile(t0, 256 * 8);
    const int m0 = (t >> 3) * 128, n0 = (t & 7) * 128;
    f32x16 acc[2][2];
    float xr[2][2][16];
    const float* xld = P.out; asm volatile("" : "+s"(xld));
    const unsigned obase_b = 4u * (unsigned)((m0 + wm * 64 + 4 * (lane >> 5)) * 1024 + n0 + wn * 64 + (lane & 31));
#pragma unroll
    for (int mb = 0; mb < 2; ++mb)
#pragma unroll
      for (int nb = 0; nb < 2; ++nb)
#pragma unroll
        for (int r = 0; r < 16; ++r) xr[mb][nb][r] = (*uoff(xld + ((mb * 32 + (r & 3) + 8 * (r >> 2)) * 1024 + nb * 32), obase_b));
    gemm_tile(smem, 44, ACT, DFF, m0, wl + WO_DOWN, DFF, n0, acc);
    float* xst = P.out; asm volatile("" : "+s"(xst));
#pragma unroll
    for (int mb = 0; mb < 2; ++mb)
#pragma unroll
      for (int nb = 0; nb < 2; ++nb)
#pragma unroll
        for (int r = 0; r < 16; ++r)
          (*uoff(xst + ((mb * 32 + (r & 3) + 8 * (r >> 2)) * 1024 + nb * 32), obase_b)) = xr[mb][nb][r] + acc[mb][nb][r];
  }
}

#define XB_TMO      128
#define XB_XCNT(j)  (256  + 64 * (j))
#define XB_XSUB(j)  (1280 + 64 * (j))
#define XB_XGEN(j)  (2304 + 64 * (j))
#define XB_TOP      3328
#define XB_TOPGEN   3392
#define XCD_BAR_WORDS 3456
#define XB_SPIN_CAP (1u << 22)
#define LAS __attribute__((address_space(3)))
DI unsigned xb_ld(unsigned* p)              { return __hip_atomic_load(p, __ATOMIC_RELAXED, __HIP_MEMORY_SCOPE_AGENT); }
DI unsigned xb_add(unsigned* p, unsigned v) { return __hip_atomic_fetch_add(p, v, __ATOMIC_RELAXED, __HIP_MEMORY_SCOPE_AGENT); }
DI unsigned xb_xcc_id() { return (unsigned)__builtin_amdgcn_s_getreg((3 << 11) | 20) & 0xFu; }
#define XB_SPIN(cond, bar) do { unsigned _sp = 0; while (cond) { __builtin_amdgcn_s_sleep(1); \
    if ((++_sp & 255u) == 0u) { if (xb_ld(&(bar)[XB_TMO])) break; if (_sp > XB_SPIN_CAP) { atomicAdd(&(bar)[XB_TMO], 1u); break; } } } } while (0)
struct XcdBarrier { unsigned* bar; unsigned x; unsigned nloc, nx; };
DI XcdBarrier xcd_barrier_post(unsigned* bar) {
  XcdBarrier b; b.bar = bar; b.x = xb_xcc_id(); b.nloc = 0u; b.nx = 0u;
  if (threadIdx.x == 0) (void)xb_add(&bar[XB_XCNT(b.x)], 1u);
  return b;
}
DI void xcd_barrier_complete(unsigned* bar, unsigned x, unsigned& nloc, unsigned& nx) {
  const unsigned G = gridDim.x * gridDim.y * gridDim.z;
  unsigned sum, cnt, mine, sp = 0u;
  for (;;) {
    sum = 0u; cnt = 0u; mine = 0u;
#pragma unroll
    for (unsigned j = 0; j < 16; ++j) { const unsigned c = xb_ld(&bar[XB_XCNT(j)]); sum += c; cnt += (c > 0u) ? 1u : 0u; mine = (j == x) ? c : mine; }
    if (sum == G) break;
    __builtin_amdgcn_s_sleep(1);
    if ((++sp & 255u) == 0u) { if (xb_ld(&bar[XB_TMO])) break; if (sp > XB_SPIN_CAP) { atomicAdd(&bar[XB_TMO], 1u); break; } }
  }
  nloc = mine > 0u ? mine : 1u; nx = cnt > 0u ? cnt : 1u;
}
DI void xcd_barrier(XcdBarrier& b) {
  asm volatile("s_waitcnt vmcnt(0)" ::: "memory");
  __syncthreads();
  if (threadIdx.x == 0) {
    unsigned* bar = b.bar;
    __builtin_amdgcn_s_waitcnt(0);
    unsigned nloc = b.nloc, nx = b.nx;
    if (nloc == 0u) { xcd_barrier_complete(bar, b.x, nloc, nx); b.nloc = nloc; b.nx = nx; }
    const unsigned old = xb_add(&bar[XB_XSUB(b.x)], 1u);
    const unsigned gen = old / nloc;
    if (old + 1u == (gen + 1u) * nloc) {
      __builtin_amdgcn_fence(__ATOMIC_RELEASE, "agent");
      asm volatile("s_waitcnt vmcnt(0)" ::: "memory");
      const unsigned og = xb_add(&bar[XB_TOP], 1u);
      const unsigned tg = og / nx;
      if (og + 1u == (tg + 1u) * nx) xb_add(&bar[XB_TOPGEN], 1u);
      else XB_SPIN(xb_ld(&bar[XB_TOPGEN]) == tg, bar);
      __builtin_amdgcn_fence(__ATOMIC_ACQUIRE, "agent");
      xb_add(&bar[XB_XGEN(b.x)], 1u);
      asm volatile("s_waitcnt vmcnt(0)" ::: "memory");
    } else {
      XB_SPIN(xb_ld(&bar[XB_XGEN(b.x)]) == gen, bar);
      __builtin_amdgcn_fence(__ATOMIC_ACQUIRE, "agent");
      asm volatile("s_waitcnt vmcnt(0)" ::: "memory");
    }
  }
  __syncthreads();
}

constexpr int PH_PER_LAYER = 11;
constexpr int NPHASES = 2 * PH_PER_LAYER;

DI void run_phase(const Params& P, int ph, char* smem, unsigned xcc) {
  const int layer = ph / PH_PER_LAYER, p = ph % PH_PER_LAYER;
  const float* xin = layer == 0 ? P.x : P.out;
  bf16* HN = (bf16*)(P.ws + OFF_HN);
  switch (p) {
    case 0:
      if (layer == 0) phase_convert(P, smem);
      phase_zero_mask(P);
      phase_rmsnorm(xin, P.norm_mix + layer * 1024, HN);
      break;
    case 1: phase_gemm_in(P, layer, smem); break;
    case 2: phase_token_a(P, layer, smem); break;
    case 3: phase_gemm_lat(P, layer, smem); break;
    case 4: phase_token_c(P, layer, smem); phase_indexer(P, layer, smem, xcc); break;
    case 5: phase_attention(P, layer, smem, xcc); phase_rmsnorm(xin, P.norm_mix + layer * 1024, HN); break;
    case 6: phase_merge(P, layer, smem); break;
    case 7: phase_out(P, layer, xin, smem); break;
    case 8: phase_rmsnorm(P.out, P.norm_ffn + layer * 1024, HN); break;
    case 9: phase_up(P, layer, smem); break;
    case 10: phase_down(P, layer, smem); break;
  }
}

__global__ void __launch_bounds__(256, 2) mega_kernel(Params P, int ph_begin, int ph_end) {
  __shared__ __attribute__((aligned(1024))) char smem[65536];
  cg::grid_group grid = cg::this_grid();
  XcdBarrier xb = xcd_barrier_post((unsigned*)(P.ws + OFF_BAR));
  for (int ph = ph_begin; ph < ph_end; ++ph) {
    run_phase(P, ph, smem, xb.x);
    if (ph + 1 < ph_end) {
      if (ph_end > 1000) grid.sync();
      else xcd_barrier(xb);
    }
  }
}

extern "C" void kernel_launch(void* const* d_in, const int* in_sizes, int n_in, void* d_out, int out_size, void* d_ws,
                              size_t ws_size, hipStream_t stream) {
  Params P{};
  P.x = (const float*)d_in[0]; P.rel_bias = (const float*)d_in[1]; P.norm_mix = (const float*)d_in[2];
  P.w_in = (const float*)d_in[3]; P.a_q_norm = (const float*)d_in[4]; P.a_k_norm = (const float*)d_in[5];
  P.b_cq_norm = (const float*)d_in[6]; P.b_ckv_norm = (const float*)d_in[7]; P.b_w_uq = (const float*)d_in[8];
  P.b_w_ukv = (const float*)d_in[9]; P.b_q_norm = (const float*)d_in[10]; P.b_k_norm = (const float*)d_in[11];
  P.w_proj_a = (const float*)d_in[12]; P.w_proj_b = (const float*)d_in[13]; P.b_gate = (const float*)d_in[14];
  P.w_out = (const float*)d_in[15]; P.norm_ffn = (const float*)d_in[16]; P.w_up = (const float*)d_in[17];
  P.conv_w = (const float*)d_in[18]; P.conv_b = (const float*)d_in[19]; P.w_down = (const float*)d_in[20];
  P.out = (float*)d_out; P.ws = (char*)d_ws;
  static int grid_blocks = 0;
  if (!grid_blocks) {
    int dev = 0, cus = 0, per_cu = 0;
    hipGetDevice(&dev);
    hipDeviceGetAttribute(&cus, hipDeviceAttributeMultiprocessorCount, dev);
    hipOccupancyMaxActiveBlocksPerMultiprocessor(&per_cu, mega_kernel, 256, 0);
    if (per_cu > 2) per_cu = 2;
    if (per_cu < 1) per_cu = 1;
    grid_blocks = cus * per_cu;
  }
#if MULTI_LAUNCH
  for (int ph = 0; ph < NPHASES; ++ph) {
    hipLaunchKernelGGL(mega_kernel, dim3(grid_blocks), dim3(256), 0, stream, P, ph, ph + 1);
  }
#else
  hipMemsetAsync((char*)d_ws + OFF_BAR, 0, 65536, stream);
  int b = 0, e = NPHASES;
  void* args[] = {&P, &b, &e};
  hipError_t err = hipLaunchCooperativeKernel((void*)mega_kernel, dim3(grid_blocks), dim3(256), args, 0, stream);
  if (err != hipSuccess) fprintf(stderr, "cooperative launch failed: %s (grid %d)\n", hipGetErrorString(err), grid_blocks);
#endif
}
```

```cpp
#include <hip/hip_runtime.h>
#include <hip/hip_cooperative_groups.h>
#include <cstdio>
namespace cg = cooperative_groups;

#ifndef MULTI_LAUNCH
#define MULTI_LAUNCH 0
#endif

typedef __bf16 bf16;
using bf16x8 = __attribute__((ext_vector_type(8))) __bf16;
using bf16x2 = __attribute__((ext_vector_type(2))) __bf16;
using f16x8  = __attribute__((ext_vector_type(8))) _Float16;
using f32x16 = __attribute__((ext_vector_type(16))) float;
using f32x4  = __attribute__((ext_vector_type(4))) float;
using f32x2  = __attribute__((ext_vector_type(2))) float;
using u32x4  = __attribute__((ext_vector_type(4))) unsigned;
using u32x2  = __attribute__((ext_vector_type(2))) unsigned;
using u32x8  = __attribute__((ext_vector_type(8))) unsigned;
#define DI __device__ __forceinline__

constexpr int T_ = 32768, S_ = 16384, DM = 1024;
constexpr int ZLD = 2816;
constexpr int C_QA = 0, C_KA = 512, C_VA = 1024, C_QI = 1536, C_KI = 2048, C_WI = 2112, C_CQ = 2120, C_CKV = 2504, C_KR = 2760;
constexpr int INC = 4840, C_GA = 2792, C_GB = 3816;
constexpr int DFF = 2816;
constexpr float EPS = 1e-6f;
constexpr float LOG2E = 1.4426950408889634f;

constexpr size_t WO_IN = 0;
constexpr size_t WO_UQ = WO_IN + (size_t)INC * 1024;
constexpr size_t WO_UKV = WO_UQ + 768 * 384;
constexpr size_t WO_PA = WO_UKV + 1024 * 256;
constexpr size_t WO_PB = WO_PA + 1024 * 512;
constexpr size_t WO_OUT = WO_PB + 1024 * 512;
constexpr size_t WO_UP = WO_OUT + 1024 * 1024;
constexpr size_t WO_DOWN = WO_UP + (size_t)5632 * 1024;
constexpr size_t W_LAYER = WO_DOWN + (size_t)1024 * 2816;

constexpr size_t MiB = 1048576;
constexpr size_t OFF_WT = 0;
constexpr size_t OFF_HN = 63 * MiB;
constexpr size_t OFF_MASK = 127 * MiB;
constexpr size_t OFF_Z = 160 * MiB;
constexpr size_t OFF_QB = 336 * MiB;
constexpr size_t OFF_KB = 384 * MiB;
constexpr size_t OFF_VTA = 432 * MiB;
constexpr size_t OFF_VTB = 464 * MiB;
constexpr size_t OFF_BAR = 500 * MiB;
constexpr size_t OFF_CTR = 500 * MiB + 16384;
constexpr size_t OFF_ZPAGE = 500 * MiB + 32768;
constexpr size_t MASK_WORDS_B = 4210688;
constexpr size_t MASK_BYTES = MASK_WORDS_B * 2 * 4;

struct Params {
  const float* x; const float* rel_bias; const float* norm_mix; const float* w_in; const float* a_q_norm; const float* a_k_norm;
  const float* b_cq_norm; const float* b_ckv_norm; const float* b_w_uq; const float* b_w_ukv; const float* b_q_norm; const float* b_k_norm;
  const float* w_proj_a; const float* w_proj_b; const float* b_gate; const float* w_out; const float* norm_ffn; const float* w_up;
  const float* conv_w; const float* conv_b; const float* w_down;
  float* out; char* ws;
};

DI int ltid() { int t = threadIdx.x; asm volatile("" : "+v"(t)); return t; }
DI unsigned short f2bf(float f) { return __builtin_bit_cast(unsigned short, (__bf16)f); }
DI unsigned pk2(float a, float b) { f32x2 v = {a, b}; return __builtin_bit_cast(unsigned, __builtin_convertvector(v, bf16x2)); }
DI float bf2f(unsigned short u) { return __uint_as_float(((unsigned)u) << 16); }
DI float bflo(unsigned u) { return __uint_as_float(u << 16); }
DI float bfhi(unsigned u) { return __uint_as_float(u & 0xffff0000u); }
DI unsigned short f2h(float f) { return __builtin_bit_cast(unsigned short, (_Float16)f); }
DI float wave_sum(float v) {
#pragma unroll
  for (int o = 32; o >= 1; o >>= 1) v += __shfl_xor(v, o);
  return v;
}
template <class T> DI T* uoff(T* base, unsigned byteoff) { return (T*)((char*)base + byteoff); }
template <class T> DI const T* uoff(const T* base, unsigned byteoff) { return (const T*)((const char*)base + byteoff); }
DI int xcd_tile(int t, int total) {
  const int local = t >> 3, l = local & 63;
  const int nl = (local & ~63) | (((l & 31) << 1) | (l >> 5));
  const int chunk = total >> 3;
  return (t & 7) * chunk + (((local | 63) < chunk) ? nl : local);
}
DI int mask_base(int b, int c) { return b * (int)MASK_WORDS_B + c * (c + 1) * 64; }

constexpr int STAGE_B = 32768;
#define WAIT_V0() asm volatile("s_waitcnt vmcnt(0)" ::: "memory")
DI void gemm_core(char* smem, int nk, const char* Ab, const char* Bb, const unsigned (&aoff)[4], const unsigned (&boff)[4],
                  f32x16 (&acc)[2][2]) {
  const int tid = ltid(), lane = tid & 63, w = tid >> 6;
  const int wm = w >> 1, wn = w & 1;
#pragma unroll
  for (int mb = 0; mb < 2; ++mb)
#pragma unroll
    for (int nb = 0; nb < 2; ++nb)
#pragma unroll
      for (int i = 0; i < 16; ++i) acc[mb][nb][i] = 0.f;
  const int l31 = lane & 31, H = lane >> 5, x = (l31 >> 1) & 7;
  const int a_base = (wm * 64 + l31) * 128, b_base = 16384 + (wn * 64 + l31) * 128;
  int xo[4];
#pragma unroll
  for (int ks = 0; ks < 4; ++ks) xo[ks] = ((2 * ks + H) ^ x) << 4;
  auto stage = [&](int buf, int kt) __attribute__((always_inline)) {
    const char* ak = Ab + kt * 128;
    const char* bk = Bb + kt * 128;
    char* sa = smem + buf * STAGE_B + w * 4096;
#pragma unroll
    for (int i = 0; i < 4; ++i) {
      __builtin_amdgcn_global_load_lds((const unsigned*)(ak + aoff[i]), (unsigned*)(sa + i * 1024), 16, 0, 0);
      __builtin_amdgcn_global_load_lds((const unsigned*)(bk + boff[i]), (unsigned*)(sa + 16384 + i * 1024), 16, 0, 0);
    }
  };
  stage(0, 0);
  WAIT_V0();
  __syncthreads();
  for (int kt = 0; kt < nk; ++kt) {
    const int cur = kt & 1;
    if (kt + 1 < nk) stage(cur ^ 1, kt + 1);
    const char* sb = smem + cur * STAGE_B;
#pragma unroll
    for (int ks = 0; ks < 4; ++ks) {
      bf16x8 af[2], bfr[2];
#pragma unroll
      for (int mb = 0; mb < 2; ++mb) af[mb] = *(const bf16x8*)(sb + a_base + mb * 4096 + xo[ks]);
#pragma unroll
      for (int nb = 0; nb < 2; ++nb) bfr[nb] = *(const bf16x8*)(sb + b_base + nb * 4096 + xo[ks]);
#pragma unroll
      for (int mb = 0; mb < 2; ++mb)
#pragma unroll
        for (int nb = 0; nb < 2; ++nb)
          acc[mb][nb] = __builtin_amdgcn_mfma_f32_32x32x16_bf16(af[mb], bfr[nb], acc[mb][nb], 0, 0, 0);
    }
    WAIT_V0();
    __syncthreads();
  }
}

DI int glds_row(int i) { const int tid = ltid(); return ((tid >> 6) * 4 + i) * 8 + ((tid & 63) >> 3); }
DI int glds_chunk(int row) { return (ltid() & 7) ^ ((row >> 1) & 7); }

template <class F>
DI void epi_foreach(const f32x16 (&acc)[2][2], F f) {
  const int lane = ltid() & 63, w = ltid() >> 6;
  const int wm = w >> 1, wn = w & 1;
#pragma unroll
  for (int mb = 0; mb < 2; ++mb)
#pragma unroll
    for (int nb = 0; nb < 2; ++nb)
#pragma unroll
      for (int r = 0; r < 16; ++r) {
        const int row = wm * 64 + mb * 32 + (r & 3) + 8 * (r >> 2) + 4 * (lane >> 5);
        const int col = wn * 64 + nb * 32 + (lane & 31);
        f(row, col, acc[mb][nb][r]);
        if ((r & 7) == 7) __builtin_amdgcn_sched_barrier(0);
      }
}

DI void store_tile16(const unsigned short* Cs, unsigned short* dst, int ldd) {
  const int tid = ltid();
#pragma unroll
  for (int i = 0; i < 8; ++i) {
    const int idx = tid + 256 * i;
    const int row = idx >> 4, c8 = (idx & 15) * 8;
    *(u32x4*)(dst + (size_t)row * ldd + c8) = *(const u32x4*)(Cs + row * 136 + c8);
  }
}

DI void gemm_tile(char* smem, int nk, const bf16* A, int lda, int m0, const bf16* Bt, int ldb, int n0, f32x16 (&acc)[2][2]) {
  unsigned aoff[4], boff[4];
#pragma unroll
  for (int i = 0; i < 4; ++i) {
    const int row = glds_row(i), ch = glds_chunk(row);
    aoff[i] = (unsigned)((row * lda + ch * 8) * 2);
    boff[i] = (unsigned)((row * ldb + ch * 8) * 2);
  }
  gemm_core(smem, nk, (const char*)(A + (size_t)m0 * lda), (const char*)(Bt + (size_t)n0 * ldb), aoff, boff, acc);
}

DI void transpose_tile(const float* src, bf16* dst, int K, int N, int t, char* smem) {
  unsigned short* ts = (unsigned short*)smem;
  const int tid = ltid();
  const int ntn = (N + 63) >> 6;
  const int n0 = (t % ntn) * 64, k0 = (t / ntn) * 64;
  {
    const int n4 = (tid & 15) * 4, kb = tid >> 4;
#pragma unroll
    for (int i = 0; i < 4; ++i) {
      const int k = kb + 16 * i;
      float4 v = {0.f, 0.f, 0.f, 0.f};
      if (n0 + n4 < N) v = *(const float4*)(src + (size_t)(k0 + k) * N + n0 + n4);
      ts[(n4 + 0) * 66 + k] = f2bf(v.x); ts[(n4 + 1) * 66 + k] = f2bf(v.y);
      ts[(n4 + 2) * 66 + k] = f2bf(v.z); ts[(n4 + 3) * 66 + k] = f2bf(v.w);
    }
  }
  __syncthreads();
  {
    const int n = tid >> 2, kc = tid & 3;
    if (n0 + n < N) {
      const unsigned* rp = (const unsigned*)(ts + n * 66 + kc * 16);
      u32x4 a = {rp[0], rp[1], rp[2], rp[3]}, b = {rp[4], rp[5], rp[6], rp[7]};
      u32x4* dp = (u32x4*)(dst + (size_t)(n0 + n) * K + k0 + kc * 16);
      dp[0] = a; dp[1] = b;
    }
  }
  __syncthreads();
}

DI void phase_convert(const Params& P, char* smem) {
  bf16* wt = (bf16*)(P.ws + OFF_WT);
  constexpr int NW = 8;
  const int Ks[NW] = {1024, 384, 256, 512, 512, 1024, 1024, 2816};
  const int Ns[NW] = {INC, 768, 1024, 1024, 1024, 1024, 5632, 1024};
  int total = 0;
#pragma unroll
  for (int i = 0; i < NW; ++i) total += ((Ns[i] + 63) >> 6) * (Ks[i] >> 6);
  for (int t = blockIdx.x; t < 2 * total; t += gridDim.x) {
    const int l = t >= total ? 1 : 0;
    int r = t - l * total;
    bf16* wl = wt + l * W_LAYER;
    const float* src = nullptr; bf16* dst = nullptr; int K = 64, N = 64;
    bool found = false;
#pragma unroll
    for (int i = 0; i < NW; ++i) {
      const int nt = ((Ns[i] + 63) >> 6) * (Ks[i] >> 6);
      if (!found && r < nt) {
        found = true; K = Ks[i]; N = Ns[i];
        const size_t lo = (size_t)l * Ks[i] * Ns[i];
        src = (i == 0 ? P.w_in : i == 1 ? P.b_w_uq : i == 2 ? P.b_w_ukv : i == 3 ? P.w_proj_a : i == 4 ? P.w_proj_b : i == 5 ? P.w_out : i == 6 ? P.w_up : P.w_down) + lo;
        dst = wl + (i == 0 ? WO_IN : i == 1 ? WO_UQ : i == 2 ? WO_UKV : i == 3 ? WO_PA : i == 4 ? WO_PB : i == 5 ? WO_OUT : i == 6 ? WO_UP : WO_DOWN);
      }
      if (!found) r -= nt;
    }
    transpose_tile(src, dst, K, N, r, smem);
  }
}

DI void phase_rmsnorm(const float* x, const float* g, bf16* hn) {
  const int lane = ltid() & 63, w = ltid() >> 6;
  for (int t = blockIdx.x * 4 + w; t < T_; t += gridDim.x * 4) {
    const float4* xr = (const float4*)(x + (size_t)t * DM);
    float4 v[4];
    float ss = 0.f;
#pragma unroll
    for (int i = 0; i < 4; ++i) {
      v[i] = xr[lane + 64 * i];
      ss += v[i].x * v[i].x + v[i].y * v[i].y + v[i].z * v[i].z + v[i].w * v[i].w;
    }
    ss = wave_sum(ss);
    const float r = rsqrtf(ss * (1.f / DM) + EPS);
#pragma unroll
    for (int i = 0; i < 4; ++i) {
      const float4 gg = ((const float4*)g)[lane + 64 * i];
      u32x2 o;
      o.x = pk2(v[i].x * r * gg.x, v[i].y * r * gg.y);
      o.y = pk2(v[i].z * r * gg.z, v[i].w * r * gg.w);
      *(u32x2*)(hn + (size_t)t * DM + (lane + 64 * i) * 4) = o;
    }
  }
}

DI void phase_zero_mask(const Params& P) {
  u32x4* m = (u32x4*)(P.ws + OFF_MASK);
  const size_t n = MASK_BYTES / 16;
  const u32x4 z = {0u, 0u, 0u, 0u};
  for (size_t i = (size_t)blockIdx.x * 256 + ltid(); i < n; i += (size_t)gridDim.x * 256) m[i] = z;
}

DI void phase_gemm_in(const Params& P, int layer, char* smem) {
  const bf16* hn = (const bf16*)(P.ws + OFF_HN);
  const bf16* wt = (const bf16*)(P.ws + OFF_WT) + layer * W_LAYER + WO_IN;
  unsigned short* Z = (unsigned short*)(P.ws + OFF_Z);
  constexpr int NT = 22, MT = 256;
  for (int t0 = blockIdx.x; t0 < NT * MT; t0 += gridDim.x) {
    const int tl = xcd_tile(t0, NT * MT) - (t0 & 7) * ((NT * MT) >> 3);
    const int m0 = ((t0 & 3) * 64 + tl / 11) * 128, n0 = (((t0 & 7) >> 2) * 11 + tl % 11) * 128;
    f32x16 acc[2][2];
    gemm_tile(smem, 16, hn, 1024, m0, wt, 1024, n0, acc);
    unsigned short* Cs = (unsigned short*)smem;
    epi_foreach(acc, [&](int row, int col, float v) __attribute__((always_inline)) {
      const int c = n0 + col;
      Cs[row * 136 + col] = (c >= C_QI && c < C_CQ) ? f2h(v) : f2bf(v);
    });
    __syncthreads();
    store_tile16(Cs, Z + (size_t)m0 * ZLD + n0, ZLD);
    __syncthreads();
  }
}

DI void transpose_v(const unsigned short* src, int ld, int col0, int hs, unsigned short* dst, char* smem) {
  unsigned short* ts = (unsigned short*)smem;
  const int tid = ltid();
  const int nitems = (T_ / 64) * 8;
  for (int it = blockIdx.x; it < nitems; it += gridDim.x) {
    const int h = it & 7, tg = it >> 3;
    const int t0 = tg * 64;
#pragma unroll
    for (int i = 0; i < 2; ++i) {
      const int r = (tid >> 3) + 32 * i, ch = tid & 7;
      u32x4 v = *(const u32x4*)(src + (size_t)(t0 + r) * ld + col0 + h * hs + ch * 8);
      *(u32x4*)(ts + r * 72 + ch * 8) = v;
    }
    __syncthreads();
    const int b = t0 / S_, s0 = t0 % S_;
#pragma unroll
    for (int i = 0; i < 2; ++i) {
      const int dv = (tid >> 3) + 32 * i, c = tid & 7;
      unsigned short e[8];
#pragma unroll
      for (int j = 0; j < 8; ++j) e[j] = ts[(8 * c + j) * 72 + dv];
      u32x4 o;
      o.x = e[0] | ((unsigned)e[1] << 16); o.y = e[2] | ((unsigned)e[3] << 16);
      o.z = e[4] | ((unsigned)e[5] << 16); o.w = e[6] | ((unsigned)e[7] << 16);
      *(u32x4*)(dst + ((size_t)((b * 8 + h) * 64 + dv)) * S_ + s0 + 8 * c) = o;
    }
    __syncthreads();
  }
}

DI void phase_token_a(const Params& P, int layer, char* smem) {
  unsigned short* Z = (unsigned short*)(P.ws + OFF_Z);
  const int lane = ltid() & 63, w = ltid() >> 6;
  const float* gq = P.a_q_norm + layer * 64;
  const float* gk = P.a_k_norm + layer * 64;
  const float* gcq = P.b_cq_norm + layer * 384;
  const float* gckv = P.b_ckv_norm + layer * 256;
  for (int t = blockIdx.x * 4 + w; t < T_; t += gridDim.x * 4) {
    unsigned short* zr = Z + (size_t)t * ZLD;
#pragma unroll
    for (int which = 0; which < 2; ++which) {
      const float* g = which ? gk : gq;
      u32x4* p = (u32x4*)(zr + (which ? C_KA : C_QA) + lane * 8);
      u32x4 u = *p;
      float f[8] = {bflo(u.x), bfhi(u.x), bflo(u.y), bfhi(u.y), bflo(u.z), bfhi(u.z), bflo(u.w), bfhi(u.w)};
      float ss = 0.f;
#pragma unroll
      for (int j = 0; j < 8; ++j) ss += f[j] * f[j];
      ss += __shfl_xor(ss, 1); ss += __shfl_xor(ss, 2); ss += __shfl_xor(ss, 4);
      const float r = rsqrtf(ss * (1.f / 64) + EPS);
      const int c0 = (lane & 7) * 8;
#pragma unroll
      for (int j = 0; j < 8; ++j) f[j] = f[j] * r * g[c0 + j];
      u.x = pk2(f[0], f[1]); u.y = pk2(f[2], f[3]); u.z = pk2(f[4], f[5]); u.w = pk2(f[6], f[7]);
      *p = u;
    }
    {
      unsigned* p = (unsigned*)(zr + C_CQ + lane * 6);
      unsigned u0 = p[0], u1 = p[1], u2 = p[2];
      float f[6] = {bflo(u0), bfhi(u0), bflo(u1), bfhi(u1), bflo(u2), bfhi(u2)};
      float ss = 0.f;
#pragma unroll
      for (int j = 0; j < 6; ++j) ss += f[j] * f[j];
      ss = wave_sum(ss);
      const float r = rsqrtf(ss * (1.f / 384) + EPS);
#pragma unroll
      for (int j = 0; j < 6; ++j) f[j] = f[j] * r * gcq[lane * 6 + j];
      p[0] = pk2(f[0], f[1]); p[1] = pk2(f[2], f[3]); p[2] = pk2(f[4], f[5]);
    }
    {
      u32x2* p = (u32x2*)(zr + C_CKV + lane * 4);
      u32x2 u = *p;
      float f[4] = {bflo(u.x), bfhi(u.x), bflo(u.y), bfhi(u.y)};
      float ss = f[0] * f[0] + f[1] * f[1] + f[2] * f[2] + f[3] * f[3];
      ss = wave_sum(ss);
      const float r = rsqrtf(ss * (1.f / 256) + EPS);
#pragma unroll
      for (int j = 0; j < 4; ++j) f[j] = f[j] * r * gckv[lane * 4 + j];
      u.x = pk2(f[0], f[1]); u.y = pk2(f[2], f[3]);
      *p = u;
    }
    {
      const int i = lane & 15;
      const float x1 = bf2f(zr[C_KR + i]), x2 = bf2f(zr[C_KR + 16 + i]);
      const float inv = powf(10000.f, -(float)i / 16.f);
      const float ang = (float)(t % S_) * inv;
      float sn, cs;
      sincosf(ang, &sn, &cs);
      const float o1 = x1 * cs - x2 * sn, o2 = x1 * sn + x2 * cs;
      if (lane < 16) { zr[C_KR + i] = f2bf(o1); zr[C_KR + 16 + i] = f2bf(o2); }
    }
  }
  __syncthreads();
  transpose_v(Z, ZLD, C_VA, 64, (unsigned short*)(P.ws + OFF_VTA), smem);
}

DI void phase_gemm_lat(const Params& P, int layer, char* smem) {
  const bf16* Z = (const bf16*)(P.ws + OFF_Z);
  const bf16* wl = (const bf16*)(P.ws + OFF_WT) + layer * W_LAYER;
  unsigned short* QB = (unsigned short*)(P.ws + OFF_QB);
  unsigned short* KV = (unsigned short*)(P.ws + OFF_HN);
  constexpr int MT = 256;
  for (int t0 = blockIdx.x; t0 < MT * 14; t0 += gridDim.x) {
    const int t = xcd_tile(t0, MT * 14);
    const int mt = t / 14, nt = t % 14;
    const int m0 = mt * 128;
    const bool isq = nt < 6;
    const int n0 = (isq ? nt : nt - 6) * 128;
    f32x16 acc[2][2];
    gemm_tile(smem, isq ? 6 : 4, Z + (isq ? C_CQ : C_CKV), ZLD, m0, wl + (isq ? WO_UQ : WO_UKV), isq ? 384 : 256, n0, acc);
    unsigned short* dst = isq ? QB : KV;
    const int ldd = isq ? 768 : 1024;
    unsigned short* Cs = (unsigned short*)smem;
    epi_foreach(acc, [&](int row, int col, float v) __attribute__((always_inline)) { Cs[row * 136 + col] = f2bf(v); });
    __syncthreads();
    store_tile16(Cs, dst + (size_t)m0 * ldd + n0, ldd);
    __syncthreads();
  }
}

DI void phase_token_c(const Params& P, int layer, char* smem) {
  const unsigned short* Z = (const unsigned short*)(P.ws + OFF_Z);
  unsigned short* QB = (unsigned short*)(P.ws + OFF_QB);
  unsigned short* KB = (unsigned short*)(P.ws + OFF_KB);
  const unsigned short* KV = (const unsigned short*)(P.ws + OFF_HN);
  const int lane = ltid() & 63, w = ltid() >> 6;
  float* rowbuf = (float*)smem + w * 800;
  const float* gq = P.b_q_norm + layer * 96;
  const float* gk = P.b_k_norm + layer * 96;
  const int ngroups = T_ / 4;
  for (int gi = blockIdx.x; gi < ngroups; gi += gridDim.x) {
    const int t = gi * 4 + w;
    unsigned short* qr = QB + (size_t)t * 768;
#pragma unroll
    for (int i = 0; i < 3; ++i) {
      const u32x2 u = *(const u32x2*)(qr + (lane + 64 * i) * 4);
      float4 f = {bflo(u.x), bfhi(u.x), bflo(u.y), bfhi(u.y)};
      *(float4*)(rowbuf + (lane + 64 * i) * 4) = f;
    }
    if (lane < 16) {
      const float inv = powf(10000.f, -(float)lane / 16.f);
      const float ang = (float)(t % S_) * inv;
      float sn, cs;
      sincosf(ang, &sn, &cs);
      rowbuf[768 + lane] = cs; rowbuf[784 + lane] = sn;
    }
    __syncthreads();
    {
      float f[12];
      float ss = 0.f;
      const int hd = lane >> 3, j0 = (lane & 7) * 12;
#pragma unroll
      for (int e = 0; e < 12; ++e) {
        const int j = j0 + e;
        float v;
        if (j < 64) v = rowbuf[hd * 96 + j];
        else {
          const int i = (j - 64) & 15;
          const float x1 = rowbuf[hd * 96 + 64 + i], x2 = rowbuf[hd * 96 + 80 + i];
          const float cs = rowbuf[768 + i], sn = rowbuf[784 + i];
          v = (j < 80) ? (x1 * cs - x2 * sn) : (x1 * sn + x2 * cs);
        }
        f[e] = v; ss += v * v;
      }
      ss += __shfl_xor(ss, 1); ss += __shfl_xor(ss, 2); ss += __shfl_xor(ss, 4);
      const float r = rsqrtf(ss * (1.f / 96) + EPS);
      unsigned o[6];
#pragma unroll
      for (int e = 0; e < 6; ++e) o[e] = pk2(f[2 * e] * r * gq[j0 + 2 * e], f[2 * e + 1] * r * gq[j0 + 2 * e + 1]);
      u32x2* op = (u32x2*)(qr + lane * 12);
      op[0] = u32x2{o[0], o[1]}; op[1] = u32x2{o[2], o[3]}; op[2] = u32x2{o[4], o[5]};
    }
    {
      float f[12];
      float ss = 0.f;
      const int hd = lane >> 3, j0 = (lane & 7) * 12;
#pragma unroll
      for (int e = 0; e < 12; ++e) {
        const int j = j0 + e;
        const float v = (j < 64) ? bf2f(KV[(size_t)t * 1024 + hd * 128 + j]) : bf2f(Z[(size_t)t * ZLD + C_KR + (j - 64)]);
        f[e] = v; ss += v * v;
      }
      ss += __shfl_xor(ss, 1); ss += __shfl_xor(ss, 2); ss += __shfl_xor(ss, 4);
      const float r = rsqrtf(ss * (1.f / 96) + EPS);
      unsigned o[6];
#pragma unroll
      for (int e = 0; e < 6; ++e) o[e] = pk2(f[2 * e] * r * gk[j0 + 2 * e], f[2 * e + 1] * r * gk[j0 + 2 * e + 1]);
      u32x2* op = (u32x2*)(KB + ((size_t)((t / S_) * 8 + hd) * S_ + (t % S_)) * 96 + j0);
      op[0] = u32x2{o[0], o[1]}; op[1] = u32x2{o[2], o[3]}; op[2] = u32x2{o[4], o[5]};
    }
    __syncthreads();
  }
  __syncthreads();
  transpose_v(KV, 1024, 64, 128, (unsigned short*)(P.ws + OFF_VTB), smem);
}

DI unsigned f2o(float f) { unsigned u = __float_as_uint(f); return u ^ ((u >> 31) ? 0xffffffffu : 0x80000000u); }
DI float o2f(unsigned u) { return __uint_as_float(u ^ ((u >> 31) ? 0x80000000u : 0xffffffffu)); }

DI void topk_compact(float* sc, unsigned short* ix, int* cntp, float* taup, int lane) {
  const int n = *cntp;
  unsigned u[8]; unsigned id[8]; bool valid[8];
#pragma unroll
  for (int i = 0; i < 8; ++i) {
    const int p = lane + 64 * i;
    valid[i] = p < n;
    u[i] = valid[i] ? f2o(sc[p]) : 0u;
    id[i] = valid[i] ? (unsigned)ix[p] : 0xffffu;
  }
  unsigned prefix = 0; int kk = 256;
  for (int bit = 31; bit >= 0; --bit) {
    const unsigned cand = (prefix >> bit) | 1u;
    int c = 0;
#pragma unroll
    for (int i = 0; i < 8; ++i) c += __popcll(__ballot(valid[i] && ((u[i] >> bit) == cand)));
    if (c >= kk) prefix |= (1u << bit); else kk -= c;
  }
  int ceq = 0;
#pragma unroll
  for (int i = 0; i < 8; ++i) ceq += __popcll(__ballot(valid[i] && u[i] == prefix));
  unsigned idthr = 0xffffu;
  if (ceq != kk) {
    unsigned p2 = 0; int k2 = kk;
    for (int bit = 13; bit >= 0; --bit) {
      int c0 = 0;
#pragma unroll
      for (int i = 0; i < 8; ++i) c0 += __popcll(__ballot(valid[i] && u[i] == prefix && ((id[i] >> bit) == (p2 >> bit))));
      if (c0 < k2) { k2 -= c0; p2 |= (1u << bit); }
    }
    idthr = p2;
  }
  int base = 0;
  const unsigned long long lt = (1ull << lane) - 1ull;
#pragma unroll
  for (int i = 0; i < 8; ++i) {
    const bool keep = valid[i] && (u[i] > prefix || (u[i] == prefix && id[i] <= idthr));
    const unsigned long long m = __ballot(keep);
    if (keep) {
      const int pos = base + __popcll(m & lt);
      sc[pos] = o2f(u[i]); ix[pos] = (unsigned short)id[i];
    }
    base += __popcll(m);
  }
  if (lane == 0) { *cntp = base; *taup = o2f(prefix); }
}

constexpr int HB_LO = 124 * 16, HB_P = 192, HB_WORDS = 387;

template <int MODE>
DI void indexer_pass(const _Float16* kbase, int ntile_in, int ts, const f16x8 (&qf)[8][2], const f16x8 (&qc)[2], const float (&wq)[8], float* csc,
                     unsigned short* cix, int* cnt, float* tau, unsigned* hist, int* oflow, int lane, int w) {
  constexpr int NG = (MODE == 2) ? 2 : 4;
  const int ntile = (ntile_in + ts - 1) / ts;
  const int q = lane & 15, kg = lane >> 4;
  const int nstep = (ntile + NG - 1) / NG;
  f16x8 cur[NG][2], nxt[NG][2];
#pragma unroll
  for (int g = 0; g < NG; ++g) {
    int tl = g; tl = tl < ntile ? tl : ntile - 1;
    cur[g][0] = *(const f16x8*)(kbase + (size_t)(tl * ts) * 64 * ZLD);
    cur[g][1] = *(const f16x8*)(kbase + (size_t)(tl * ts) * 64 * ZLD + 32);
  }
  float tq = (MODE == 0) ? 0.f : tau[q];
  for (int st = 0; st < nstep; ++st) {
#pragma unroll
    for (int g = 0; g < NG; ++g) {
      int tl = NG * (st + 1) + g; tl = tl < ntile ? tl : ntile - 1;
      nxt[g][0] = *(const f16x8*)(kbase + (size_t)(tl * ts) * 64 * ZLD);
      nxt[g][1] = *(const f16x8*)(kbase + (size_t)(tl * ts) * 64 * ZLD + 32);
    }
    if (MODE == 2) tq = tau[q];
#pragma unroll
    for (int g = 0; g < NG; ++g) {
      const int tl = NG * st + g;
      if (tl < ntile) {
        f32x4 lin = {0.f, 0.f, 0.f, 0.f};
        lin = __builtin_amdgcn_mfma_f32_16x16x32_f16(cur[g][0], qc[0], lin, 0, 0, 0);
        lin = __builtin_amdgcn_mfma_f32_16x16x32_f16(cur[g][1], qc[1], lin, 0, 0, 0);
        float s[4] = {lin[0], lin[1], lin[2], lin[3]};
        f32x4 accp = {0.f, 0.f, 0.f, 0.f};
        accp = __builtin_amdgcn_mfma_f32_16x16x32_f16(cur[g][0], qf[0][0], accp, 0, 0, 0);
        accp = __builtin_amdgcn_mfma_f32_16x16x32_f16(cur[g][1], qf[0][1], accp, 0, 0, 0);
#pragma unroll
        for (int h = 0; h < 8; ++h) {
          f32x4 accn = {0.f, 0.f, 0.f, 0.f};
          if (h < 7) {
            accn = __builtin_amdgcn_mfma_f32_16x16x32_f16(cur[g][0], qf[h + 1][0], accn, 0, 0, 0);
            accn = __builtin_amdgcn_mfma_f32_16x16x32_f16(cur[g][1], qf[h + 1][1], accn, 0, 0, 0);
          }
          __builtin_amdgcn_sched_barrier(0);
#pragma unroll
          for (int r = 0; r < 4; ++r) {
            s[r] = fmaf(wq[h], __builtin_fabsf(accp[r]), s[r]);
            asm("" : "+v"(s[r]));
          }
          __builtin_amdgcn_sched_barrier(0);
          accp = accn;
        }
        if (MODE == 0) {
#pragma unroll
          for (int r = 0; r < 4; ++r) {
            const float score = s[r] + 0.f;
            const unsigned bits = __float_as_uint(score);
            int p = (int)((bits & 0x7fffffffu) >> 19) - (HB_LO - 1);
            p = p < 0 ? 0 : (p > HB_P ? HB_P : p);
            const int bin = (bits >> 31) ? (HB_P - p) : (HB_P + 1 + p);
            atomicAdd(hist + q * HB_WORDS + bin, 1u);
          }
        } else {
          float sc4[4]; bool ps[4]; int np = 0;
#pragma unroll
          for (int r = 0; r < 4; ++r) { sc4[r] = s[r] + 0.f; ps[r] = sc4[r] > tq; np += ps[r] ? 1 : 0; }
          if (__ballot(np > 0)) {
            int pos = q * 512 + atomicAdd(&cnt[q], np);
            const int lim = q * 512 + 512;
            if (MODE != 2) { if (__ballot(pos + np > lim)) { if (pos + np > lim) *oflow = 1; } }
            const int dummy = 16 * 512 + lane;
            const unsigned kbase16 = (unsigned)(tl * 64 + w * 16 + kg * 4);
#pragma unroll
            for (int r = 0; r < 4; ++r) {
              const bool ok = ps[r] && (MODE == 2 || pos < lim);
              const int idx = ok ? pos : dummy;
              csc[idx] = sc4[r];
              cix[idx] = (unsigned short)(kbase16 + r);
              pos += ps[r] ? 1 : 0;
            }
          }
        }
      }
    }
    if (MODE == 2) {
      __syncthreads();
#pragma unroll 1
      for (int jj = 0; jj < 4; ++jj) {
        const int qq = w * 4 + jj;
        if (cnt[qq] > 384) topk_compact(csc + qq * 512, cix + qq * 512, cnt + qq, tau + qq, lane);
      }
      __syncthreads();
    }
#pragma unroll
    for (int g = 0; g < NG; ++g) { cur[g][0] = nxt[g][0]; cur[g][1] = nxt[g][1]; }
  }
}

DI void phase_indexer(const Params& P, int layer, char* smem, unsigned xcc) {
  float* csc = (float*)(smem);
  unsigned short* cix = (unsigned short*)(smem + 34816);
  unsigned* hist = (unsigned*)(smem);
  int* cnt = (int*)(smem + 52224);
  float* tau = (float*)(cnt + 16);
  int* oflow = cnt + 32;
  const int tid = ltid(), lane = tid & 63, w = tid >> 6;
  const _Float16* Zh = (const _Float16*)(P.ws + OFF_Z);
  unsigned* mask = (unsigned*)(P.ws + OFF_MASK);
  unsigned* ctr = (unsigned*)(P.ws + OFF_CTR) + (2 + layer) * 8 * 16;
  volatile int* slot = (volatile int*)(smem + 65528);
  for (int dq = 0; dq < 8; ++dq)
  for (;;) {
    const int qx = (int)((xcc + dq) & 7u);
    __syncthreads();
    if (tid == 0) *slot = (int)atomicAdd(ctr + qx * 16, 1u);
    __syncthreads();
    const int r = *slot;
    if (r >= 256) break;
    const int c = 255 - r;
    const int b = qx >> 2, qsub = qx & 3;
    const int t0 = b * S_ + c * 64 + qsub * 16;
    if (c < 4) {
      if (tid < 2 * (c + 1) * 16) {
        const int kb = tid >> 4, ql = qsub * 16 + (tid & 15);
        mask[mask_base(b, c) + kb * 64 + ql] = 0xffffffffu;
      }
      continue;
    }
    const int q = lane & 15, kg = lane >> 4;
    f16x8 qf[8][2];
#pragma unroll
    for (int h = 0; h < 8; ++h)
#pragma unroll
      for (int ks = 0; ks < 2; ++ks)
        qf[h][ks] = *(const f16x8*)(Zh + (size_t)(t0 + q) * ZLD + C_QI + h * 64 + ks * 32 + kg * 8);
    float wq[8];
    {
      const f16x8 wv = *(const f16x8*)(Zh + (size_t)(t0 + q) * ZLD + C_WI);
#pragma unroll
      for (int h = 0; h < 8; ++h) wq[h] = (float)wv[h];
    }
    f16x8 qc[2];
#pragma unroll
    for (int ks = 0; ks < 2; ++ks)
#pragma unroll
      for (int jx = 0; jx < 8; ++jx) {
        float a = 0.f;
#pragma unroll
        for (int h = 0; h < 8; ++h) a = fmaf(wq[h], (float)qf[h][ks][jx], a);
        qc[ks][jx] = (_Float16)a;
      }
    const _Float16* kbase = Zh + (size_t)(b * S_ + w * 16 + q) * ZLD + C_KI + kg * 8;
    const int ntile = c + 1;
    for (int attempt = (ntile > 16) ? 0 : 1;; ++attempt) {
      __syncthreads();
      for (int i = tid; i < 16 * HB_WORDS; i += 256) hist[i] = 0u;
      if (tid < 16) { cnt[tid] = 0; tau[tid] = -INFINITY; }
      if (tid == 0) *oflow = 0;
      __syncthreads();
      if (attempt >= 2) {
        indexer_pass<2>(kbase, ntile, 1, qf, qc, wq, csc, cix, cnt, tau, hist, oflow, lane, w);
        break;
      }
      const int ts = attempt == 0 ? 2 : 1;
      indexer_pass<0>(kbase, ntile, ts, qf, qc, wq, csc, cix, cnt, tau, hist, oflow, lane, w);
      __syncthreads();
      if (tid < 16) {
        const int nsamp = (ntile + ts - 1) / ts;
        const int target = attempt == 0 ? (328 * nsamp + ntile - 1) / ntile : 256;
        const unsigned* hq = hist + tid * HB_WORDS;
        int cum = 0, B = 0;
        for (int bin = 2 * HB_P + 1; bin >= 0; --bin) {
          cum += (int)hq[bin];
          if (cum >= target) { B = bin; break; }
        }
        float t;
        if (B > HB_P) {
          const int p = B - HB_P - 1;
          t = (p == 0) ? -1e-30f : __uint_as_float((((unsigned)(p + HB_LO - 1)) << 19) - 1u);
        } else {
          const int p = HB_P - B;
          t = (p == HB_P) ? -INFINITY : -__uint_as_float(((unsigned)(p + HB_LO)) << 19);
        }
        tau[tid] = t;
      }
      __syncthreads();
      indexer_pass<1>(kbase, ntile, 1, qf, qc, wq, csc, cix, cnt, tau, hist, oflow, lane, w);
      __syncthreads();
      if (tid < 16 && cnt[tid] < 256) *oflow = 1;
      __syncthreads();
      if (!*oflow) break;
    }
#pragma unroll 1
    for (int jj = 0; jj < 4; ++jj) {
      const int qq = w * 4 + jj;
      if (cnt[qq] > 256) topk_compact(csc + qq * 512, cix + qq * 512, cnt + qq, tau + qq, lane);
      unsigned* mrow = mask + mask_base(b, c) + (qsub * 16 + qq);
#pragma unroll
      for (int i = 0; i < 4; ++i) {
        const unsigned key = cix[qq * 512 + lane + 64 * i];
        atomicOr(mrow + (key >> 5) * 64, 1u << (key & 31));
      }
    }
    __syncthreads();
  }
}

DI int t5_bucket(int rel) {
  const int n = rel < 0 ? -rel : rel;
  int bkt;
  if (n < 8) bkt = n; else if (n < 12) bkt = 8; else if (n < 16) bkt = 9; else if (n < 23) bkt = 10; else if (n < 32) bkt = 11;
  else if (n < 46) bkt = 12; else if (n < 64) bkt = 13; else if (n < 91) bkt = 14; else bkt = 15;
  return bkt + (rel > 0 ? 16 : 0);
}

template <int DQK, bool MIXA, bool PIPE>
DI void attn_item(const Params& P, int layer, char* smem, int b, int h, int qt) {
  constexpr int NS = DQK / 16;
  constexpr int KCH = DQK / 8;
  constexpr int KROWB = DQK * 2;
  constexpr int KTILE_B = 64 * KROWB;
  constexpr int STG_B = 20480;
  constexpr int NKI = KTILE_B / 4096;
  float* biasT = (float*)(smem + 2 * STG_B);
  const int tid = ltid(), lane = tid & 63, w = tid >> 6;
  const int H = lane >> 5, l31 = lane & 31;
  const unsigned short* Z = (const unsigned short*)(P.ws + OFF_Z);
  const unsigned short *Qp, *Kp, *VT;
  int ldq, ldk;
  unsigned short* Yp = (unsigned short*)(P.ws + OFF_Z);
  if (MIXA) {
    Qp = Z + C_QA + h * 64; Kp = Z + C_KA + h * 64 + (size_t)b * S_ * ZLD; ldq = ZLD; ldk = ZLD;
    VT = (const unsigned short*)(P.ws + OFF_VTA) + (size_t)((b * 8 + h) * 64) * S_;
    Yp += C_VA + h * 64;
  } else {
    Qp = (const unsigned short*)(P.ws + OFF_QB) + h * 96; ldq = 768;
    Kp = (const unsigned short*)(P.ws + OFF_KB) + (size_t)(b * 8 + h) * S_ * 96; ldk = 96;
    VT = (const unsigned short*)(P.ws + OFF_VTB) + (size_t)((b * 8 + h) * 64) * S_;
    Yp += C_QI + h * 64;
  }
  const unsigned* mask = (const unsigned*)(P.ws + OFF_MASK);
  const int tq0 = qt * 128 + w * 32;
  const int qpos = tq0 + l31;
  const int cw = tq0 >> 6;
  const size_t tokq = (size_t)b * S_ + qpos;
  const float sl2 = (MIXA ? 0.125f : 0.10206207261596575f) * LOG2E;
  float mfix;
  {
    const float* g1 = MIXA ? (P.a_q_norm + layer * 64) : (P.b_q_norm + layer * 96);
    const float* g2 = MIXA ? (P.a_k_norm + layer * 64) : (P.b_k_norm + layer * 96);
    float a1 = 0.f, a2 = 0.f;
    for (int i = 0; i < DQK; ++i) { a1 = fmaxf(a1, fabsf(g1[i])); a2 = fmaxf(a2, fabsf(g2[i])); }
    mfix = (float)DQK * 1.02f * a1 * a2 * sl2;
    if (MIXA) {
      const float b15 = P.rel_bias[15 * 8 + h];
      float bm = 0.f;
      for (int i = 0; i < 32; ++i) bm = fmaxf(bm, P.rel_bias[i * 8 + h] - b15);
      mfix += bm * LOG2E;
    }
  }
  if (MIXA) {
    const int rel = tid - 192;
    const float b15 = P.rel_bias[15 * 8 + h];
    biasT[tid] = (P.rel_bias[t5_bucket(rel) * 8 + h] - b15) * LOG2E;
  }
  bf16x8 qf[NS];
#pragma unroll
  for (int s = 0; s < NS; ++s) qf[s] = *(const bf16x8*)(Qp + tokq * ldq + 16 * s + 8 * H);
  const int nkt = 2 * qt + 2;
  unsigned koff[NKI], voff[2];
#pragma unroll
  for (int i = 0; i < NKI; ++i) {
    const int e = (w * NKI + i) * 64 + lane;
    const int row = e / KCH, slot = e % KCH;
    const int c = slot ^ (MIXA ? ((row >> 1) & 7) : ((row >> 2) & 3));
    koff[i] = (unsigned)((row * ldk + c * 8) * 2);
  }
#pragma unroll
  for (int i = 0; i < 2; ++i) {
    const int e = (w * 2 + i) * 64 + lane;
    const int row = e >> 3, slot = e & 7;
    const int c = slot ^ ((row >> 1) & 7);
    voff[i] = (unsigned)((row * S_ + c * 8) * 2);
  }
  unsigned mwn[2] = {0u, 0u};
  auto issue_loads = [&](int kt) __attribute__((always_inline)) {
    const char* kbp = (const char*)(Kp + (size_t)(kt * 64) * ldk);
    const char* vbp = (const char*)(VT + kt * 64);
    char* sk = smem + (kt & 1) * STG_B;
#pragma unroll
    for (int i = 0; i < NKI; ++i)
      __builtin_amdgcn_global_load_lds((const unsigned*)(kbp + koff[i]), (unsigned*)(sk + (w * NKI + i) * 1024), 16, 0, 0);
#pragma unroll
    for (int i = 0; i < 2; ++i)
      __builtin_amdgcn_global_load_lds((const unsigned*)(vbp + voff[i]), (unsigned*)(sk + KTILE_B + (w * 2 + i) * 1024), 16, 0, 0);
    if (MIXA) {
      if (kt <= cw) {
        const unsigned* mp = mask + mask_base(b, cw) + (2 * kt) * 64 + (qpos & 63);
        mwn[0] = mp[0]; mwn[1] = mp[64];
      }
    }
  };
  issue_loads(0);
  f32x16 o[2];
#pragma unroll
  for (int d = 0; d < 2; ++d)
#pragma unroll
    for (int i = 0; i < 16; ++i) o[d][i] = 0.f;
  float l = 0.f;
  const int pr = (l31 & ~12) | ((l31 & 4) << 1) | ((l31 & 8) >> 1);
  const int swk = MIXA ? ((pr >> 1) & 7) : ((pr >> 2) & 3), swv = (l31 >> 1) & 7;
  asm volatile("s_waitcnt vmcnt(0)" ::: "memory");
  __syncthreads();
  for (int kt = 0; kt < nkt; ++kt) {
    unsigned mw[2] = {mwn[0], mwn[1]};
    if (kt + 1 < nkt) issue_loads(kt + 1);
    const char* Ks = smem + (kt & 1) * STG_B;
    const char* Vs = Ks + KTILE_B;
    if (kt <= cw) {
      const int kc = kt;
      bf16x8 kf[2][NS];
#pragma unroll
      for (int kb = 0; kb < 2; ++kb)
#pragma unroll
        for (int s = 0; s < NS; ++s) kf[kb][s] = *(const bf16x8*)(Ks + (32 * kb + pr) * KROWB + (((2 * s + H) ^ swk) << 4));
      __builtin_amdgcn_sched_barrier(0);
      f32x16 sacc[2];
#pragma unroll
      for (int kb = 0; kb < 2; ++kb)
#pragma unroll
        for (int i = 0; i < 16; ++i) sacc[kb][i] = 0.f;
#pragma unroll
      for (int s = 0; s < NS; ++s) sacc[0] = __builtin_amdgcn_mfma_f32_32x32x16_bf16(kf[0][s], qf[s], sacc[0], 0, 0, 0);
      bf16x8 vf[2][2][2];
#pragma unroll
      for (int d = 0; d < 2; ++d)
#pragma unroll
        for (int kb = 0; kb < 2; ++kb)
#pragma unroll
          for (int s2 = 0; s2 < 2; ++s2)
            vf[d][kb][s2] = *(const bf16x8*)(Vs + (d * 32 + l31) * 128 + (((4 * kb + 2 * s2 + H) ^ swv) << 4));
      __builtin_amdgcn_sched_barrier(0);
      const bool near = MIXA && (kc >= cw - 2);
      f32x2 ls2 = {0.f, 0.f};
      const f32x2 sl2v = {sl2, sl2}, mfixv = {mfix, mfix};
      unsigned pkw[2][2][4];
      unsigned mrot[2];
#pragma unroll
      for (int kb = 0; kb < 2; ++kb) mrot[kb] = MIXA ? ((mw[kb] >> (8 * H)) << 8) : 0u;
      auto chunk = [&](int kb, int c) __attribute__((always_inline)) {
        const int s2 = 1 - (c >> 2), e = 3 - (c & 3);
        const int r0 = 8 * s2 + 2 * e;
        if (MIXA && c == 4) mrot[kb] <<= 8;
        f32x2 xv2 = {sacc[kb][r0], sacc[kb][r0 + 1]};
        xv2 = xv2 * sl2v - mfixv;
        if (MIXA) {
          if (near) {
            const int kl = 16 * (r0 >> 3) + 8 * H + (r0 & 7);
            const int rel = kc * 64 + 32 * kb + kl - qpos;
            xv2.x += biasT[rel + 192];
            xv2.y += biasT[rel + 193];
          }
        }
        f32x2 p2 = {__builtin_amdgcn_exp2f(xv2.x), __builtin_amdgcn_exp2f(xv2.y)};
        if (MIXA) {
          float px = p2.x, py = p2.y;
          asm volatile("v_add_co_u32 %0, vcc, %0, %0\n\tv_cndmask_b32 %1, 0, %1, vcc" : "+v"(mrot[kb]), "+v"(py) : : "vcc");
          asm volatile("v_add_co_u32 %0, vcc, %0, %0\n\tv_cndmask_b32 %1, 0, %1, vcc" : "+v"(mrot[kb]), "+v"(px) : : "vcc");
          p2.x = px; p2.y = py;
        }
        ls2 += p2;
        pkw[kb][s2][e] = pk2(p2.x, p2.y);
      };
      {
        int c0 = 0;
#pragma unroll
        for (int s = 0; s < NS; ++s) {
          sacc[1] = __builtin_amdgcn_mfma_f32_32x32x16_bf16(kf[1][s], qf[s], sacc[1], 0, 0, 0);
          const int cend = (8 * (s + 1)) / NS;
#pragma unroll
          for (int c = 0; c < 8; ++c) if (c >= c0 && c < cend) chunk(0, c);
          c0 = cend;
          __builtin_amdgcn_sched_barrier(0);
        }
      }
      bf16x8 pf0[2], pf1[2];
#pragma unroll
      for (int s2 = 0; s2 < 2; ++s2) { u32x4 t = {pkw[0][s2][0], pkw[0][s2][1], pkw[0][s2][2], pkw[0][s2][3]}; pf0[s2] = __builtin_bit_cast(bf16x8, t); }
#pragma unroll
      for (int j = 0; j < 4; ++j) {
        const int s2 = j >> 1, d = j & 1;
        o[d] = __builtin_amdgcn_mfma_f32_32x32x16_bf16(vf[d][0][s2], pf0[s2], o[d], 0, 0, 0);
        chunk(1, 2 * j); chunk(1, 2 * j + 1);
        __builtin_amdgcn_sched_barrier(0);
      }
#pragma unroll
      for (int s2 = 0; s2 < 2; ++s2) { u32x4 t = {pkw[1][s2][0], pkw[1][s2][1], pkw[1][s2][2], pkw[1][s2][3]}; pf1[s2] = __builtin_bit_cast(bf16x8, t); }
#pragma unroll
      for (int j = 0; j < 4; ++j) {
        const int s2 = j >> 1, d = j & 1;
        o[d] = __builtin_amdgcn_mfma_f32_32x32x16_bf16(vf[d][1][s2], pf1[s2], o[d], 0, 0, 0);
      }
      l += ls2.x + ls2.y;
    }
    asm volatile("s_waitcnt vmcnt(0)" ::: "memory");
    __syncthreads();
  }
  const float lt = l + __shfl_xor(l, 32);
  const float inv = 1.f / lt;
  unsigned short* yr = Yp + tokq * ZLD;
#pragma unroll
  for (int d = 0; d < 2; ++d)
#pragma unroll
    for (int g = 0; g < 4; ++g) {
      u32x2 ov;
      ov.x = pk2(o[d][4 * g] * inv, o[d][4 * g + 1] * inv);
      ov.y = pk2(o[d][4 * g + 2] * inv, o[d][4 * g + 3] * inv);
      *(u32x2*)(yr + d * 32 + 8 * g + 4 * H) = ov;
    }
}

#ifndef PIPE_MLA
#define PIPE_MLA false
#endif
#ifndef PIPE_MIXA
#define PIPE_MIXA false
#endif
DI void phase_attention(const Params& P, int layer, char* smem, unsigned xcc) {
  unsigned* ctr = (unsigned*)(P.ws + OFF_CTR) + layer * 8 * 16;
  volatile int* slot = (volatile int*)(smem + 65528);
  const int tid = ltid();
  for (int d = 0; d < 8; ++d) {
    const int h = (int)((xcc + d) & 7u);
    for (;;) {
      if (tid == 0) *slot = (int)atomicAdd(ctr + h * 16, 1u);
      __syncthreads();
      const int r = *slot;
      __syncthreads();
      if (r >= 512) break;
      const int qt = 127 - (r & 127);
      const int mixer = (r >> 8) & 1, b = (r >> 7) & 1;
      if (mixer) attn_item<96, false, PIPE_MLA>(P, layer, smem, b, h, qt);
      else attn_item<64, true, PIPE_MIXA>(P, layer, smem, b, h, qt);
    }
  }
}

DI float sigmoidf_(float v) { return __builtin_amdgcn_rcpf(1.f + __expf(-v)); }

DI void phase_merge(const Params& P, int layer, char* smem) {
  const bf16* hn = (const bf16*)(P.ws + OFF_HN);
  const bf16* Z = (const bf16*)(P.ws + OFF_Z);
  const bf16* wl = (const bf16*)(P.ws + OFF_WT) + layer * W_LAYER;
  unsigned short* MG = (unsigned short*)(P.ws + OFF_QB);
  unsigned short* TG = (unsigned short*)(P.ws + OFF_VTA);
  const float* bg = P.b_gate + layer * 2048;
  for (int t0 = blockIdx.x; t0 < 256 * 8; t0 += gridDim.x) {
    const int t = xcd_tile(t0, 256 * 8);
    const int m0 = (t >> 3) * 128, n0 = (t & 7) * 128;
#pragma unroll 1
    for (int step = 0; step < 4; ++step) {
      f32x16 acc[2][2];
      const bool gate = step < 2;
      const bf16* A = gate ? hn : (Z + (step == 2 ? C_VA : C_QI));
      const bf16* Bt = wl + (step == 0 ? WO_IN + (size_t)C_GA * 1024 : step == 1 ? WO_IN + (size_t)C_GB * 1024 : step == 2 ? WO_PA : WO_PB);
      gemm_tile(smem, gate ? 16 : 8, A, gate ? 1024 : ZLD, m0, Bt, gate ? 1024 : 512, n0, acc);
      if (gate) {
        unsigned short* dst = step == 0 ? MG : TG;
        const float* bgs = bg + (step == 0 ? 0 : 1024);
        unsigned short* Cs = (unsigned short*)smem;
        epi_foreach(acc, [&](int row, int col, float v) __attribute__((always_inline)) {
          Cs[row * 136 + col] = f2bf(sigmoidf_(v + bgs[n0 + col]));
        });
        __syncthreads();
        store_tile16(Cs, dst + (size_t)m0 * 1024 + n0, 1024);
        __syncthreads();
      } else {
        unsigned short* Cs = (unsigned short*)smem;
        epi_foreach(acc, [&](int row, int col, float v) __attribute__((always_inline)) { Cs[row * 136 + col] = f2bf(v); });
        __syncthreads();
        const int tid_ = ltid();
#pragma unroll 2
        for (int i = 0; i < 8; ++i) {
          const int idx = tid_ + 256 * i;
          const int row = idx >> 4, c8 = (idx & 15) * 8;
          u32x4* gp = (u32x4*)(MG + (size_t)(m0 + row) * 1024 + n0 + c8);
          const u32x4 mg = *gp;
          const u32x4 pj = *(const u32x4*)(Cs + row * 136 + c8);
          u32x4 ov;
          if (step == 2) {
#pragma unroll
            for (int e = 0; e < 4; ++e) ov[e] = pk2(bflo(mg[e]) * bflo(pj[e]), bfhi(mg[e]) * bfhi(pj[e]));
          } else {
            const u32x4 tg = *(const u32x4*)(TG + (size_t)(m0 + row) * 1024 + n0 + c8);
#pragma unroll
            for (int e = 0; e < 4; ++e) ov[e] = pk2(bflo(mg[e]) + bflo(tg[e]) * bflo(pj[e]), bfhi(mg[e]) + bfhi(tg[e]) * bfhi(pj[e]));
          }
          *gp = ov;
        }
        __syncthreads();
      }
    }
  }
}

DI void phase_out(const Params& P, int layer, const float* xin, char* smem) {
  const bf16* MG = (const bf16*)(P.ws + OFF_QB);
  const bf16* wl = (const bf16*)(P.ws + OFF_WT) + layer * W_LAYER;
  const int lane = ltid() & 63, w = ltid() >> 6;
  const int wm = w >> 1, wn = w & 1;
  for (int t0 = blockIdx.x; t0 < 256 * 8; t0 += gridDim.x) {
    const int t = xcd_tile(t0, 256 * 8);
    const int m0 = (t >> 3) * 128, n0 = (t & 7) * 128;
    f32x16 acc[2][2];
    float xr[2][2][16];
    const unsigned obase_b = 4u * (unsigned)((m0 + wm * 64 + 4 * (lane >> 5)) * 1024 + n0 + wn * 64 + (lane & 31));
#pragma unroll
    for (int mb = 0; mb < 2; ++mb)
#pragma unroll
      for (int nb = 0; nb < 2; ++nb)
#pragma unroll
        for (int r = 0; r < 16; ++r) xr[mb][nb][r] = (*uoff(xin + ((mb * 32 + (r & 3) + 8 * (r >> 2)) * 1024 + nb * 32), obase_b));
    gemm_tile(smem, 16, MG, 1024, m0, wl + WO_OUT, 1024, n0, acc);
#pragma unroll
    for (int mb = 0; mb < 2; ++mb)
#pragma unroll
      for (int nb = 0; nb < 2; ++nb)
#pragma unroll
        for (int r = 0; r < 16; ++r)
          (*uoff(P.out + ((mb * 32 + (r & 3) + 8 * (r >> 2)) * 1024 + nb * 32), obase_b)) = xr[mb][nb][r] + acc[mb][nb][r];
  }
}

DI void phase_up(const Params& P, int layer, char* smem) {
  const bf16* hn = (const bf16*)(P.ws + OFF_HN);
  const bf16* wup = (const bf16*)(P.ws + OFF_WT) + layer * W_LAYER + WO_UP;
  unsigned short* ACT = (unsigned short*)(P.ws + OFF_Z);
  const float* cw = P.conv_w + (size_t)layer * 3 * 5632;
  const float* cb = P.conv_b + (size_t)layer * 5632;
  unsigned short* Cs = (unsigned short*)smem;
  const int tid = ltid();
  constexpr int MT = 262, NT = 44;
  for (int t0 = blockIdx.x; t0 < MT * NT; t0 += gridDim.x) {
    const int tl = xcd_tile(t0, MT * NT) - (t0 & 7) * ((MT * NT) >> 3);
    const int mt = (t0 & 1) * 131 + tl / 11, nt = ((t0 & 7) >> 1) * 11 + tl % 11;
    const int b = mt / 131, i = mt % 131;
    const int tb0 = i * 126 - 2;
    unsigned aoff[4], boff[4];
    const char* Abase = (const char*)(hn + (size_t)b * S_ * 1024);
    const unsigned zoff = (unsigned)((P.ws + OFF_ZPAGE) - Abase);
#pragma unroll
    for (int q = 0; q < 4; ++q) {
      const int r = glds_row(q), ch = glds_chunk(r);
      const int tb = tb0 + r;
      const bool ok = (tb >= 0) && (tb < S_);
      aoff[q] = ok ? (unsigned)((tb * 1024 + ch * 8) * 2) : zoff;
      const int wr = (r < 64) ? (nt * 64 + r) : (DFF + nt * 64 + r - 64);
      boff[q] = (unsigned)((wr * 1024 + ch * 8) * 2);
    }
    f32x16 acc[2][2];
    gemm_core(smem, 16, Abase, (const char*)wup, aoff, boff, acc);
    epi_foreach(acc, [&](int row, int col, float v) __attribute__((always_inline)) { Cs[row * 136 + col] = f2bf(v); });
    __syncthreads();
    {
      const int col = tid & 63, rb = tid >> 6;
      const int cv = nt * 64 + col, cg_ = DFF + nt * 64 + col;
      const float w0v = cw[cv], w1v = cw[5632 + cv], w2v = cw[2 * 5632 + cv], bv = cb[cv];
      const float w0g = cw[cg_], w1g = cw[5632 + cg_], w2g = cw[2 * 5632 + cg_], bgt = cb[cg_];
      for (int r = 2 + rb; r < 128; r += 4) {
        const int tb = tb0 + r;
        if (tb < S_) {
          const float val = bv + w0v * bf2f(Cs[(r - 2) * 136 + col]) + w1v * bf2f(Cs[(r - 1) * 136 + col]) + w2v * bf2f(Cs[r * 136 + col]);
          const float gat = bgt + w0g * bf2f(Cs[(r - 2) * 136 + 64 + col]) + w1g * bf2f(Cs[(r - 1) * 136 + 64 + col]) + w2g * bf2f(Cs[r * 136 + 64 + col]);
          const float a = gat / (1.f + __expf(-gat)) * val;
          ACT[(size_t)(b * S_ + tb) * DFF + cv] = f2bf(a);
        }
      }
    }
    __syncthreads();
  }
}

DI void phase_down(const Params& P, int layer, char* smem) {
  const bf16* ACT = (const bf16*)(P.ws + OFF_Z);
  const bf16* wl = (const bf16*)(P.ws + OFF_WT) + layer * W_LAYER;
  const int lane = ltid() & 63, w = ltid() >> 6;
  const int wm = w >> 1, wn = w & 1;
  for (int t0 = blockIdx.x; t0 < 256 * 8; t0 += gridDim.x) {
    const int t = xcd_tile(t0, 256 * 8);
    const int m0 = (t >> 3) * 128, n0 = (t & 7) * 128;
    f32x16 acc[2][2];
    float xr[2][2][16];
    const float* xld = P.out; asm volatile("" : "+s"(xld));
    const unsigned obase_b = 4u * (unsigned)((m0 + wm * 64 + 4 * (lane >> 5)) * 1024 + n0 + wn * 64 + (lane & 31));
#pragma unroll
    for (int mb = 0; mb < 2; ++mb)
#pragma unroll
      for (int nb = 0; nb < 2; ++nb)
#pragma unroll
        for (int r = 0; r < 16; ++r) xr[mb][nb][r] = (*uoff(xld + ((mb * 32 + (r & 3) + 8 * (r >> 2)) * 1024 + nb * 32), obase_b));
    gemm_tile(smem, 44, ACT, DFF, m0, wl + WO_DOWN, DFF, n0, acc);
    float* xst = P.out; asm volatile("" : "+s"(xst));
#pragma unroll
    for (int mb = 0; mb < 2; ++mb)
#pragma unroll
      for (int nb = 0; nb < 2; ++nb)
#pragma unroll
        for (int r = 0; r < 16; ++r)
          (*uoff(xst + ((mb * 32 + (r & 3) + 8 * (r >> 2)) * 1024 + nb * 32), obase_b)) = xr[mb][nb][r] + acc[mb][nb][r];
  }
}

#define XB_TMO      128
#define XB_XCNT(j)  (256  + 64 * (j))
#define XB_XSUB(j)  (1280 + 64 * (j))
#define XB_XGEN(j)  (2304 + 64 * (j))
#define XB_TOP      3328
#define XB_TOPGEN   3392
#define XCD_BAR_WORDS 3456
#define XB_SPIN_CAP (1u << 22)
#define LAS __attribute__((address_space(3)))
DI unsigned xb_ld(unsigned* p)              { return __hip_atomic_load(p, __ATOMIC_RELAXED, __HIP_MEMORY_SCOPE_AGENT); }
DI unsigned xb_add(unsigned* p, unsigned v) { return __hip_atomic_fetch_add(p, v, __ATOMIC_RELAXED, __HIP_MEMORY_SCOPE_AGENT); }
DI unsigned xb_xcc_id() { return (unsigned)__builtin_amdgcn_s_getreg((3 << 11) | 20) & 0xFu; }
#define XB_SPIN(cond, bar) do { unsigned _sp = 0; while (cond) { __builtin_amdgcn_s_sleep(1); \
    if ((++_sp & 255u) == 0u) { if (xb_ld(&(bar)[XB_TMO])) break; if (_sp > XB_SPIN_CAP) { atomicAdd(&(bar)[XB_TMO], 1u); break; } } } } while (0)
struct XcdBarrier { unsigned* bar; unsigned x; unsigned nloc, nx; };
DI XcdBarrier xcd_barrier_post(unsigned* bar) {
  XcdBarrier b; b.bar = bar; b.x = xb_xcc_id(); b.nloc = 0u; b.nx = 0u;
  if (threadIdx.x == 0) (void)xb_add(&bar[XB_XCNT(b.x)], 1u);
  return b;
}
DI void xcd_barrier_complete(unsigned* bar, unsigned x, unsigned& nloc, unsigned& nx) {
  const unsigned G = gridDim.x * gridDim.y * gridDim.z;
  unsigned sum, cnt, mine, sp = 0u;
  for (;;) {
    sum = 0u; cnt = 0u; mine = 0u;
#pragma unroll
    for (unsigned j = 0; j < 16; ++j) { const unsigned c = xb_ld(&bar[XB_XCNT(j)]); sum += c; cnt += (c > 0u) ? 1u : 0u; mine = (j == x) ? c : mine; }
    if (sum == G) break;
    __builtin_amdgcn_s_sleep(1);
    if ((++sp & 255u) == 0u) { if (xb_ld(&bar[XB_TMO])) break; if (sp > XB_SPIN_CAP) { atomicAdd(&bar[XB_TMO], 1u); break; } }
  }
  nloc = mine > 0u ? mine : 1u; nx = cnt > 0u ? cnt : 1u;
}
DI void xcd_barrier(XcdBarrier& b) {
  asm volatile("s_waitcnt vmcnt(0)" ::: "memory");
  __syncthreads();
  if (threadIdx.x == 0) {
    unsigned* bar = b.bar;
    __builtin_amdgcn_s_waitcnt(0);
    unsigned nloc = b.nloc, nx = b.nx;
    if (nloc == 0u) { xcd_barrier_complete(bar, b.x, nloc, nx); b.nloc = nloc; b.nx = nx; }
    const unsigned old = xb_add(&bar[XB_XSUB(b.x)], 1u);
    const unsigned gen = old / nloc;
    if (old + 1u == (gen + 1u) * nloc) {
      __builtin_amdgcn_fence(__ATOMIC_RELEASE, "agent");
      asm volatile("s_waitcnt vmcnt(0)" ::: "memory");
      const unsigned og = xb_add(&bar[XB_TOP], 1u);
      const unsigned tg = og / nx;
      if (og + 1u == (tg + 1u) * nx) xb_add(&bar[XB_TOPGEN], 1u);
      else XB_SPIN(xb_ld(&bar[XB_TOPGEN]) == tg, bar);
      __builtin_amdgcn_fence(__ATOMIC_ACQUIRE, "agent");
      xb_add(&bar[XB_XGEN(b.x)], 1u);
      asm volatile("s_waitcnt vmcnt(0)" ::: "memory");
    } else {
      XB_SPIN(xb_ld(&bar[XB_XGEN(b.x)]) == gen, bar);
      __builtin_amdgcn_fence(__ATOMIC_ACQUIRE, "agent");
      asm volatile("s_waitcnt vmcnt(0)" ::: "memory");
    }
  }
  __syncthreads();
}

constexpr int PH_PER_LAYER = 11;
constexpr int NPHASES = 2 * PH_PER_LAYER;

DI void run_phase(const Params& P, int ph, char* smem, unsigned xcc) {
  const int layer = ph / PH_PER_LAYER, p = ph % PH_PER_LAYER;
  const float* xin = layer == 0 ? P.x : P.out;
  bf16* HN = (bf16*)(P.ws + OFF_HN);
  switch (p) {
    case 0:
      if (layer == 0) phase_convert(P, smem);
      phase_zero_mask(P);
      phase_rmsnorm(xin, P.norm_mix + layer * 1024, HN);
      break;
    case 1: phase_gemm_in(P, layer, smem); break;
    case 2: phase_token_a(P, layer, smem); break;
    case 3: phase_gemm_lat(P, layer, smem); break;
    case 4: phase_token_c(P, layer, smem); phase_indexer(P, layer, smem, xcc); break;
    case 5: phase_attention(P, layer, smem, xcc); phase_rmsnorm(xin, P.norm_mix + layer * 1024, HN); break;
    case 6: phase_merge(P, layer, smem); break;
    case 7: phase_out(P, layer, xin, smem); break;
    case 8: phase_rmsnorm(P.out, P.norm_ffn + layer * 1024, HN); break;
    case 9: phase_up(P, layer, smem); break;
    case 10: phase_down(P, layer, smem); break;
  }
}

__global__ void __launch_bounds__(256, 2) mega_kernel(Params P, int ph_begin, int ph_end) {
  __shared__ __attribute__((aligned(1024))) char smem[65536];
  cg::grid_group grid = cg::this_grid();
  XcdBarrier xb = xcd_barrier_post((unsigned*)(P.ws + OFF_BAR));
  for (int ph = ph_begin; ph < ph_end; ++ph) {
    run_phase(P, ph, smem, xb.x);
    if (ph + 1 < ph_end) {
      if (ph_end > 1000) grid.sync();
      else xcd_barrier(xb);
    }
  }
}

extern "C" void kernel_launch(void* const* d_in, const int* in_sizes, int n_in, void* d_out, int out_size, void* d_ws,
                              size_t ws_size, hipStream_t stream) {
  Params P{};
  P.x = (const float*)d_in[0]; P.rel_bias = (const float*)d_in[1]; P.norm_mix = (const float*)d_in[2];
  P.w_in = (const float*)d_in[3]; P.a_q_norm = (const float*)d_in[4]; P.a_k_norm = (const float*)d_in[5];
  P.b_cq_norm = (const float*)d_in[6]; P.b_ckv_norm = (const float*)d_in[7]; P.b_w_uq = (const float*)d_in[8];
  P.b_w_ukv = (const float*)d_in[9]; P.b_q_norm = (const float*)d_in[10]; P.b_k_norm = (const float*)d_in[11];
  P.w_proj_a = (const float*)d_in[12]; P.w_proj_b = (const float*)d_in[13]; P.b_gate = (const float*)d_in[14];
  P.w_out = (const float*)d_in[15]; P.norm_ffn = (const float*)d_in[16]; P.w_up = (const float*)d_in[17];
  P.conv_w = (const float*)d_in[18]; P.conv_b = (const float*)d_in[19]; P.w_down = (const float*)d_in[20];
  P.out = (float*)d_out; P.ws = (char*)d_ws;
  static int grid_blocks = 0;
  if (!grid_blocks) {
    int dev = 0, cus = 0, per_cu = 0;
    hipGetDevice(&dev);
    hipDeviceGetAttribute(&cus, hipDeviceAttributeMultiprocessorCount, dev);
    hipOccupancyMaxActiveBlocksPerMultiprocessor(&per_cu, mega_kernel, 256, 0);
    if (per_cu > 2) per_cu = 2;
    if (per_cu < 1) per_cu = 1;
    grid_blocks = cus * per_cu;
  }
#if MULTI_LAUNCH
  for (int ph = 0; ph < NPHASES; ++ph) {
    hipLaunchKernelGGL(mega_kernel, dim3(grid_blocks), dim3(256), 0, stream, P, ph, ph + 1);
  }
#else
  hipMemsetAsync((char*)d_ws + OFF_BAR, 0, 65536, stream);
  int b = 0, e = NPHASES;
  void* args[] = {&P, &b, &e};
  hipError_t err = hipLaunchCooperativeKernel((void*)mega_kernel, dim3(grid_blocks), dim3(256), args, 0, stream);
  if (err != hipSuccess) fprintf(stderr, "cooperative launch failed: %s (grid %d)\n", hipGetErrorString(err), grid_blocks);
#endif
}
```

```cpp
#include <hip/hip_runtime.h>
#include <hip/hip_cooperative_groups.h>
#include <cstdio>
namespace cg = cooperative_groups;

#ifndef MULTI_LAUNCH
#define MULTI_LAUNCH 0
#endif

typedef __bf16 bf16;
using bf16x8 = __attribute__((ext_vector_type(8))) __bf16;
using bf16x2 = __attribute__((ext_vector_type(2))) __bf16;
using f16x8  = __attribute__((ext_vector_type(8))) _Float16;
using f32x16 = __attribute__((ext_vector_type(16))) float;
using f32x4  = __attribute__((ext_vector_type(4))) float;
using f32x2  = __attribute__((ext_vector_type(2))) float;
using u32x4  = __attribute__((ext_vector_type(4))) unsigned;
using u32x2  = __attribute__((ext_vector_type(2))) unsigned;
using u32x8  = __attribute__((ext_vector_type(8))) unsigned;
#define DI __device__ __forceinline__

constexpr int T_ = 32768, S_ = 16384, DM = 1024;
constexpr int ZLD = 2816;
constexpr int C_QA = 0, C_KA = 512, C_VA = 1024, C_QI = 1536, C_KI = 2048, C_WI = 2112, C_CQ = 2120, C_CKV = 2504, C_KR = 2760;
constexpr int INC = 4840, C_GA = 2792, C_GB = 3816;
constexpr int DFF = 2816;
constexpr float EPS = 1e-6f;
constexpr float LOG2E = 1.4426950408889634f;

constexpr size_t WO_IN = 0;
constexpr size_t WO_UQ = WO_IN + (size_t)INC * 1024;
constexpr size_t WO_UKV = WO_UQ + 768 * 384;
constexpr size_t WO_PA = WO_UKV + 1024 * 256;
constexpr size_t WO_PB = WO_PA + 1024 * 512;
constexpr size_t WO_OUT = WO_PB + 1024 * 512;
constexpr size_t WO_UP = WO_OUT + 1024 * 1024;
constexpr size_t WO_DOWN = WO_UP + (size_t)5632 * 1024;
constexpr size_t W_LAYER = WO_DOWN + (size_t)1024 * 2816;

constexpr size_t MiB = 1048576;
constexpr size_t OFF_WT = 0;
constexpr size_t OFF_HN = 63 * MiB;
constexpr size_t OFF_MASK = 127 * MiB;
constexpr size_t OFF_Z = 160 * MiB;
constexpr size_t OFF_QB = 336 * MiB;
constexpr size_t OFF_KB = 384 * MiB;
constexpr size_t OFF_VTA = 432 * MiB;
constexpr size_t OFF_VTB = 464 * MiB;
constexpr size_t OFF_BAR = 500 * MiB;
constexpr size_t OFF_CTR = 500 * MiB + 16384;
constexpr size_t OFF_ZPAGE = 500 * MiB + 32768;
constexpr size_t MASK_WORDS_B = 4210688;
constexpr size_t MASK_BYTES = MASK_WORDS_B * 2 * 4;

struct Params {
  const float* x; const float* rel_bias; const float* norm_mix; const float* w_in; const float* a_q_norm; const float* a_k_norm;
  const float* b_cq_norm; const float* b_ckv_norm; const float* b_w_uq; const float* b_w_ukv; const float* b_q_norm; const float* b_k_norm;
  const float* w_proj_a; const float* w_proj_b; const float* b_gate; const float* w_out; const float* norm_ffn; const float* w_up;
  const float* conv_w; const float* conv_b; const float* w_down;
  float* out; char* ws;
};

DI int ltid() { int t = threadIdx.x; asm volatile("" : "+v"(t)); return t; }
DI unsigned short f2bf(float f) { return __builtin_bit_cast(unsigned short, (__bf16)f); }
DI unsigned pk2(float a, float b) { f32x2 v = {a, b}; return __builtin_bit_cast(unsigned, __builtin_convertvector(v, bf16x2)); }
DI float bf2f(unsigned short u) { return __uint_as_float(((unsigned)u) << 16); }
DI float bflo(unsigned u) { return __uint_as_float(u << 16); }
DI float bfhi(unsigned u) { return __uint_as_float(u & 0xffff0000u); }
DI unsigned short f2h(float f) { return __builtin_bit_cast(unsigned short, (_Float16)f); }
DI float wave_sum(float v) {
#pragma unroll
  for (int o = 32; o >= 1; o >>= 1) v += __shfl_xor(v, o);
  return v;
}
template <class T> DI T* uoff(T* base, unsigned byteoff) { return (T*)((char*)base + byteoff); }
template <class T> DI const T* uoff(const T* base, unsigned byteoff) { return (const T*)((const char*)base + byteoff); }
DI int xcd_tile(int t, int total) {
  const int local = t >> 3, l = local & 63;
  const int nl = (local & ~63) | (((l & 31) << 1) | (l >> 5));
  const int chunk = total >> 3;
  return (t & 7) * chunk + (((local | 63) < chunk) ? nl : local);
}
DI int mask_base(int b, int c) { return b * (int)MASK_WORDS_B + c * (c + 1) * 64; }

constexpr int STAGE_B = 32768;
#define WAIT_V0() asm volatile("s_waitcnt vmcnt(0)" ::: "memory")
DI void gemm_core(char* smem, int nk, const char* Ab, const char* Bb, const unsigned (&aoff)[4], const unsigned (&boff)[4],
                  f32x16 (&acc)[2][2]) {
  const int tid = ltid(), lane = tid & 63, w = tid >> 6;
  const int wm = w >> 1, wn = w & 1;
#pragma unroll
  for (int mb = 0; mb < 2; ++mb)
#pragma unroll
    for (int nb = 0; nb < 2; ++nb)
#pragma unroll
      for (int i = 0; i < 16; ++i) acc[mb][nb][i] = 0.f;
  const int l31 = lane & 31, H = lane >> 5, x = (l31 >> 1) & 7;
  const int a_base = (wm * 64 + l31) * 128, b_base = 16384 + (wn * 64 + l31) * 128;
  int xo[4];
#pragma unroll
  for (int ks = 0; ks < 4; ++ks) xo[ks] = ((2 * ks + H) ^ x) << 4;
  auto stage = [&](int buf, int kt) __attribute__((always_inline)) {
    const char* ak = Ab + kt * 128;
    const char* bk = Bb + kt * 128;
    char* sa = smem + buf * STAGE_B + w * 4096;
#pragma unroll
    for (int i = 0; i < 4; ++i) {
      __builtin_amdgcn_global_load_lds((const unsigned*)(ak + aoff[i]), (unsigned*)(sa + i * 1024), 16, 0, 0);
      __builtin_amdgcn_global_load_lds((const unsigned*)(bk + boff[i]), (unsigned*)(sa + 16384 + i * 1024), 16, 0, 0);
    }
  };
  stage(0, 0);
  WAIT_V0();
  __syncthreads();
  for (int kt = 0; kt < nk; ++kt) {
    const int cur = kt & 1;
    if (kt + 1 < nk) stage(cur ^ 1, kt + 1);
    const char* sb = smem + cur * STAGE_B;
#pragma unroll
    for (int ks = 0; ks < 4; ++ks) {
      bf16x8 af[2], bfr[2];
#pragma unroll
      for (int mb = 0; mb < 2; ++mb) af[mb] = *(const bf16x8*)(sb + a_base + mb * 4096 + xo[ks]);
#pragma unroll
      for (int nb = 0; nb < 2; ++nb) bfr[nb] = *(const bf16x8*)(sb + b_base + nb * 4096 + xo[ks]);
#pragma unroll
      for (int mb = 0; mb < 2; ++mb)
#pragma unroll
        for (int nb = 0; nb < 2; ++nb)
          acc[mb][nb] = __builtin_amdgcn_mfma_f32_32x32x16_bf16(af[mb], bfr[nb], acc[mb][nb], 0, 0, 0);
    }
    WAIT_V0();
    __syncthreads();
  }
}

DI int glds_row(int i) { const int tid = ltid(); return ((tid >> 6) * 4 + i) * 8 + ((tid & 63) >> 3); }
DI int glds_chunk(int row) { return (ltid() & 7) ^ ((row >> 1) & 7); }

template <class F>
DI void epi_foreach(const f32x16 (&acc)[2][2], F f) {
  const int lane = ltid() & 63, w = ltid() >> 6;
  const int wm = w >> 1, wn = w & 1;
#pragma unroll
  for (int mb = 0; mb < 2; ++mb)
#pragma unroll
    for (int nb = 0; nb < 2; ++nb)
#pragma unroll
      for (int r = 0; r < 16; ++r) {
        const int row = wm * 64 + mb * 32 + (r & 3) + 8 * (r >> 2) + 4 * (lane >> 5);
        const int col = wn * 64 + nb * 32 + (lane & 31);
        f(row, col, acc[mb][nb][r]);
        if ((r & 7) == 7) __builtin_amdgcn_sched_barrier(0);
      }
}

DI void store_tile16(const unsigned short* Cs, unsigned short* dst, int ldd) {
  const int tid = ltid();
#pragma unroll
  for (int i = 0; i < 8; ++i) {
    const int idx = tid + 256 * i;
    const int row = idx >> 4, c8 = (idx & 15) * 8;
    *(u32x4*)(dst + (size_t)row * ldd + c8) = *(const u32x4*)(Cs + row * 136 + c8);
  }
}

DI void gemm_tile(char* smem, int nk, const bf16* A, int lda, int m0, const bf16* Bt, int ldb, int n0, f32x16 (&acc)[2][2]) {
  unsigned aoff[4], boff[4];
#pragma unroll
  for (int i = 0; i < 4; ++i) {
    const int row = glds_row(i), ch = glds_chunk(row);
    aoff[i] = (unsigned)((row * lda + ch * 8) * 2);
    boff[i] = (unsigned)((row * ldb + ch * 8) * 2);
  }
  gemm_core(smem, nk, (const char*)(A + (size_t)m0 * lda), (const char*)(Bt + (size_t)n0 * ldb), aoff, boff, acc);
}

DI void transpose_tile(const float* src, bf16* dst, int K, int N, int t, char* smem) {
  unsigned short* ts = (unsigned short*)smem;
  const int tid = ltid();
  const int ntn = (N + 63) >> 6;
  const int n0 = (t % ntn) * 64, k0 = (t / ntn) * 64;
  {
    const int n4 = (tid & 15) * 4, kb = tid >> 4;
#pragma unroll
    for (int i = 0; i < 4; ++i) {
      const int k = kb + 16 * i;
      float4 v = {0.f, 0.f, 0.f, 0.f};
      if (n0 + n4 < N) v = *(const float4*)(src + (size_t)(k0 + k) * N + n0 + n4);
      ts[(n4 + 0) * 66 + k] = f2bf(v.x); ts[(n4 + 1) * 66 + k] = f2bf(v.y);
      ts[(n4 + 2) * 66 + k] = f2bf(v.z); ts[(n4 + 3) * 66 + k] = f2bf(v.w);
    }
  }
  __syncthreads();
  {
    const int n = tid >> 2, kc = tid & 3;
    if (n0 + n < N) {
      const unsigned* rp = (const unsigned*)(ts + n * 66 + kc * 16);
      u32x4 a = {rp[0], rp[1], rp[2], rp[3]}, b = {rp[4], rp[5], rp[6], rp[7]};
      u32x4* dp = (u32x4*)(dst + (size_t)(n0 + n) * K + k0 + kc * 16);
      dp[0] = a; dp[1] = b;
    }
  }
  __syncthreads();
}

DI void phase_convert(const Params& P, char* smem) {
  bf16* wt = (bf16*)(P.ws + OFF_WT);
  constexpr int NW = 8;
  const int Ks[NW] = {1024, 384, 256, 512, 512, 1024, 1024, 2816};
  const int Ns[NW] = {INC, 768, 1024, 1024, 1024, 1024, 5632, 1024};
  int total = 0;
#pragma unroll
  for (int i = 0; i < NW; ++i) total += ((Ns[i] + 63) >> 6) * (Ks[i] >> 6);
  for (int t = blockIdx.x; t < 2 * total; t += gridDim.x) {
    const int l = t >= total ? 1 : 0;
    int r = t - l * total;
    bf16* wl = wt + l * W_LAYER;
    const float* src = nullptr; bf16* dst = nullptr; int K = 64, N = 64;
    bool found = false;
#pragma unroll
    for (int i = 0; i < NW; ++i) {
      const int nt = ((Ns[i] + 63) >> 6) * (Ks[i] >> 6);
      if (!found && r < nt) {
        found = true; K = Ks[i]; N = Ns[i];
        const size_t lo = (size_t)l * Ks[i] * Ns[i];
        src = (i == 0 ? P.w_in : i == 1 ? P.b_w_uq : i == 2 ? P.b_w_ukv : i == 3 ? P.w_proj_a : i == 4 ? P.w_proj_b : i == 5 ? P.w_out : i == 6 ? P.w_up : P.w_down) + lo;
        dst = wl + (i == 0 ? WO_IN : i == 1 ? WO_UQ : i == 2 ? WO_UKV : i == 3 ? WO_PA : i == 4 ? WO_PB : i == 5 ? WO_OUT : i == 6 ? WO_UP : WO_DOWN);
      }
      if (!found) r -= nt;
    }
    transpose_tile(src, dst, K, N, r, smem);
  }
}

DI void phase_rmsnorm(const float* x, const float* g, bf16* hn) {
  const int lane = ltid() & 63, w = ltid() >> 6;
  for (int t = blockIdx.x * 4 + w; t < T_; t += gridDim.x * 4) {
    const float4* xr = (const float4*)(x + (size_t)t * DM);
    float4 v[4];
    float ss = 0.f;
#pragma unroll
    for (int i = 0; i < 4; ++i) {
      v[i] = xr[lane + 64 * i];
      ss += v[i].x * v[i].x + v[i].y * v[i].y + v[i].z * v[i].z + v[i].w * v[i].w;
    }
    ss = wave_sum(ss);
    const float r = rsqrtf(ss * (1.f / DM) + EPS);
#pragma unroll
    for (int i = 0; i < 4; ++i) {
      const float4 gg = ((const float4*)g)[lane + 64 * i];
      u32x2 o;
      o.x = pk2(v[i].x * r * gg.x, v[i].y * r * gg.y);
      o.y = pk2(v[i].z * r * gg.z, v[i].w * r * gg.w);
      *(u32x2*)(hn + (size_t)t * DM + (lane + 64 * i) * 4) = o;
    }
  }
}

DI void phase_zero_mask(const Params& P) {
  u32x4* m = (u32x4*)(P.ws + OFF_MASK);
  const size_t n = MASK_BYTES / 16;
  const u32x4 z = {0u, 0u, 0u, 0u};
  for (size_t i = (size_t)blockIdx.x * 256 + ltid(); i < n; i += (size_t)gridDim.x * 256) m[i] = z;
}

DI void phase_gemm_in(const Params& P, int layer, char* smem) {
  const bf16* hn = (const bf16*)(P.ws + OFF_HN);
  const bf16* wt = (const bf16*)(P.ws + OFF_WT) + layer * W_LAYER + WO_IN;
  unsigned short* Z = (unsigned short*)(P.ws + OFF_Z);
  constexpr int NT = 22, MT = 256;
  for (int t0 = blockIdx.x; t0 < NT * MT; t0 += gridDim.x) {
    const int tl = xcd_tile(t0, NT * MT) - (t0 & 7) * ((NT * MT) >> 3);
    const int m0 = ((t0 & 3) * 64 + tl / 11) * 128, n0 = (((t0 & 7) >> 2) * 11 + tl % 11) * 128;
    f32x16 acc[2][2];
    gemm_tile(smem, 16, hn, 1024, m0, wt, 1024, n0, acc);
    unsigned short* Cs = (unsigned short*)smem;
    epi_foreach(acc, [&](int row, int col, float v) __attribute__((always_inline)) {
      const int c = n0 + col;
      Cs[row * 136 + col] = (c >= C_QI && c < C_CQ) ? f2h(v) : f2bf(v);
    });
    __syncthreads();
    store_tile16(Cs, Z + (size_t)m0 * ZLD + n0, ZLD);
    __syncthreads();
  }
}

DI void transpose_v(const unsigned short* src, int ld, int col0, int hs, unsigned short* dst, char* smem) {
  unsigned short* ts = (unsigned short*)smem;
  const int tid = ltid();
  const int nitems = (T_ / 64) * 8;
  for (int it = blockIdx.x; it < nitems; it += gridDim.x) {
    const int h = it & 7, tg = it >> 3;
    const int t0 = tg * 64;
#pragma unroll
    for (int i = 0; i < 2; ++i) {
      const int r = (tid >> 3) + 32 * i, ch = tid & 7;
      u32x4 v = *(const u32x4*)(src + (size_t)(t0 + r) * ld + col0 + h * hs + ch * 8);
      *(u32x4*)(ts + r * 72 + ch * 8) = v;
    }
    __syncthreads();
    const int b = t0 / S_, s0 = t0 % S_;
#pragma unroll
    for (int i = 0; i < 2; ++i) {
      const int dv = (tid >> 3) + 32 * i, c = tid & 7;
      unsigned short e[8];
#pragma unroll
      for (int j = 0; j < 8; ++j) e[j] = ts[(8 * c + j) * 72 + dv];
      u32x4 o;
      o.x = e[0] | ((unsigned)e[1] << 16); o.y = e[2] | ((unsigned)e[3] << 16);
      o.z = e[4] | ((unsigned)e[5] << 16); o.w = e[6] | ((unsigned)e[7] << 16);
      *(u32x4*)(dst + ((size_t)((b * 8 + h) * 64 + dv)) * S_ + s0 + 8 * c) = o;
    }
    __syncthreads();
  }
}

DI void phase_token_a(const Params& P, int layer, char* smem) {
  unsigned short* Z = (unsigned short*)(P.ws + OFF_Z);
  const int lane = ltid() & 63, w = ltid() >> 6;
  const float* gq = P.a_q_norm + layer * 64;
  const float* gk = P.a_k_norm + layer * 64;
  const float* gcq = P.b_cq_norm + layer * 384;
  const float* gckv = P.b_ckv_norm + layer * 256;
  for (int t = blockIdx.x * 4 + w; t < T_; t += gridDim.x * 4) {
    unsigned short* zr = Z + (size_t)t * ZLD;
#pragma unroll
    for (int which = 0; which < 2; ++which) {
      const float* g = which ? gk : gq;
      u32x4* p = (u32x4*)(zr + (which ? C_KA : C_QA) + lane * 8);
      u32x4 u = *p;
      float f[8] = {bflo(u.x), bfhi(u.x), bflo(u.y), bfhi(u.y), bflo(u.z), bfhi(u.z), bflo(u.w), bfhi(u.w)};
      float ss = 0.f;
#pragma unroll
      for (int j = 0; j < 8; ++j) ss += f[j] * f[j];
      ss += __shfl_xor(ss, 1); ss += __shfl_xor(ss, 2); ss += __shfl_xor(ss, 4);
      const float r = rsqrtf(ss * (1.f / 64) + EPS);
      const int c0 = (lane & 7) * 8;
#pragma unroll
      for (int j = 0; j < 8; ++j) f[j] = f[j] * r * g[c0 + j];
      u.x = pk2(f[0], f[1]); u.y = pk2(f[2], f[3]); u.z = pk2(f[4], f[5]); u.w = pk2(f[6], f[7]);
      *p = u;
    }
    {
      unsigned* p = (unsigned*)(zr + C_CQ + lane * 6);
      unsigned u0 = p[0], u1 = p[1], u2 = p[2];
      float f[6] = {bflo(u0), bfhi(u0), bflo(u1), bfhi(u1), bflo(u2), bfhi(u2)};
      float ss = 0.f;
#pragma unroll
      for (int j = 0; j < 6; ++j) ss += f[j] * f[j];
      ss = wave_sum(ss);
      const float r = rsqrtf(ss * (1.f / 384) + EPS);
#pragma unroll
      for (int j = 0; j < 6; ++j) f[j] = f[j] * r * gcq[lane * 6 + j];
      p[0] = pk2(f[0], f[1]); p[1] = pk2(f[2], f[3]); p[2] = pk2(f[4], f[5]);
    }
    {
      u32x2* p = (u32x2*)(zr + C_CKV + lane * 4);
      u32x2 u = *p;
      float f[4] = {bflo(u.x), bfhi(u.x), bflo(u.y), bfhi(u.y)};
      float ss = f[0] * f[0] + f[1] * f[1] + f[2] * f[2] + f[3] * f[3];
      ss = wave_sum(ss);
      const float r = rsqrtf(ss * (1.f / 256) + EPS);
#pragma unroll
      for (int j = 0; j < 4; ++j) f[j] = f[j] * r * gckv[lane * 4 + j];
      u.x = pk2(f[0], f[1]); u.y = pk2(f[2], f[3]);
      *p = u;
    }
    {
      const int i = lane & 15;
      const float x1 = bf2f(zr[C_KR + i]), x2 = bf2f(zr[C_KR + 16 + i]);
      const float inv = powf(10000.f, -(float)i / 16.f);
      const float ang = (float)(t % S_) * inv;
      float sn, cs;
      sincosf(ang, &sn, &cs);
      const float o1 = x1 * cs - x2 * sn, o2 = x1 * sn + x2 * cs;
      if (lane < 16) { zr[C_KR + i] = f2bf(o1); zr[C_KR + 16 + i] = f2bf(o2); }
    }
  }
  __syncthreads();
  transpose_v(Z, ZLD, C_VA, 64, (unsigned short*)(P.ws + OFF_VTA), smem);
}

DI void phase_gemm_lat(const Params& P, int layer, char* smem) {
  const bf16* Z = (const bf16*)(P.ws + OFF_Z);
  const bf16* wl = (const bf16*)(P.ws + OFF_WT) + layer * W_LAYER;
  unsigned short* QB = (unsigned short*)(P.ws + OFF_QB);
  unsigned short* KV = layer == 0 ? (unsigned short*)P.out : (unsigned short*)(P.ws + OFF_HN);
  constexpr int MT = 256;
  for (int t0 = blockIdx.x; t0 < MT * 14; t0 += gridDim.x) {
    const int t = xcd_tile(t0, MT * 14);
    const int mt = t / 14, nt = t % 14;
    const int m0 = mt * 128;
    const bool isq = nt < 6;
    const int n0 = (isq ? nt : nt - 6) * 128;
    f32x16 acc[2][2];
    gemm_tile(smem, isq ? 6 : 4, Z + (isq ? C_CQ : C_CKV), ZLD, m0, wl + (isq ? WO_UQ : WO_UKV), isq ? 384 : 256, n0, acc);
    unsigned short* dst = isq ? QB : KV;
    const int ldd = isq ? 768 : 1024;
    unsigned short* Cs = (unsigned short*)smem;
    epi_foreach(acc, [&](int row, int col, float v) __attribute__((always_inline)) { Cs[row * 136 + col] = f2bf(v); });
    __syncthreads();
    store_tile16(Cs, dst + (size_t)m0 * ldd + n0, ldd);
    __syncthreads();
  }
}

DI void phase_token_c(const Params& P, int layer, char* smem) {
  const unsigned short* Z = (const unsigned short*)(P.ws + OFF_Z);
  unsigned short* QB = (unsigned short*)(P.ws + OFF_QB);
  unsigned short* KB = (unsigned short*)(P.ws + OFF_KB);
  const unsigned short* KV = layer == 0 ? (const unsigned short*)P.out : (const unsigned short*)(P.ws + OFF_HN);
  const int lane = ltid() & 63, w = ltid() >> 6;
  float* rowbuf = (float*)smem + w * 800;
  const float* gq = P.b_q_norm + layer * 96;
  const float* gk = P.b_k_norm + layer * 96;
  const int ngroups = T_ / 4;
  for (int gi = blockIdx.x; gi < ngroups; gi += gridDim.x) {
    const int t = gi * 4 + w;
    unsigned short* qr = QB + (size_t)t * 768;
#pragma unroll
    for (int i = 0; i < 3; ++i) {
      const u32x2 u = *(const u32x2*)(qr + (lane + 64 * i) * 4);
      float4 f = {bflo(u.x), bfhi(u.x), bflo(u.y), bfhi(u.y)};
      *(float4*)(rowbuf + (lane + 64 * i) * 4) = f;
    }
    if (lane < 16) {
      const float inv = powf(10000.f, -(float)lane / 16.f);
      const float ang = (float)(t % S_) * inv;
      float sn, cs;
      sincosf(ang, &sn, &cs);
      rowbuf[768 + lane] = cs; rowbuf[784 + lane] = sn;
    }
    __syncthreads();
    {
      float f[12];
      float ss = 0.f;
      const int hd = lane >> 3, j0 = (lane & 7) * 12;
#pragma unroll
      for (int e = 0; e < 12; ++e) {
        const int j = j0 + e;
        float v;
        if (j < 64) v = rowbuf[hd * 96 + j];
        else {
          const int i = (j - 64) & 15;
          const float x1 = rowbuf[hd * 96 + 64 + i], x2 = rowbuf[hd * 96 + 80 + i];
          const float cs = rowbuf[768 + i], sn = rowbuf[784 + i];
          v = (j < 80) ? (x1 * cs - x2 * sn) : (x1 * sn + x2 * cs);
        }
        f[e] = v; ss += v * v;
      }
      ss += __shfl_xor(ss, 1); ss += __shfl_xor(ss, 2); ss += __shfl_xor(ss, 4);
      const float r = rsqrtf(ss * (1.f / 96) + EPS);
      unsigned o[6];
#pragma unroll
      for (int e = 0; e < 6; ++e) o[e] = pk2(f[2 * e] * r * gq[j0 + 2 * e], f[2 * e + 1] * r * gq[j0 + 2 * e + 1]);
      u32x2* op = (u32x2*)(qr + lane * 12);
      op[0] = u32x2{o[0], o[1]}; op[1] = u32x2{o[2], o[3]}; op[2] = u32x2{o[4], o[5]};
    }
    {
      float f[12];
      float ss = 0.f;
      const int hd = lane >> 3, j0 = (lane & 7) * 12;
#pragma unroll
      for (int e = 0; e < 12; ++e) {
        const int j = j0 + e;
        const float v = (j < 64) ? bf2f(KV[(size_t)t * 1024 + hd * 128 + j]) : bf2f(Z[(size_t)t * ZLD + C_KR + (j - 64)]);
        f[e] = v; ss += v * v;
      }
      ss += __shfl_xor(ss, 1); ss += __shfl_xor(ss, 2); ss += __shfl_xor(ss, 4);
      const float r = rsqrtf(ss * (1.f / 96) + EPS);
      unsigned o[6];
#pragma unroll
      for (int e = 0; e < 6; ++e) o[e] = pk2(f[2 * e] * r * gk[j0 + 2 * e], f[2 * e + 1] * r * gk[j0 + 2 * e + 1]);
      u32x2* op = (u32x2*)(KB + ((size_t)((t / S_) * 8 + hd) * S_ + (t % S_)) * 96 + j0);
      op[0] = u32x2{o[0], o[1]}; op[1] = u32x2{o[2], o[3]}; op[2] = u32x2{o[4], o[5]};
    }
    __syncthreads();
  }
  __syncthreads();
  transpose_v(KV, 1024, 64, 128, (unsigned short*)(P.ws + OFF_VTB), smem);
}

DI unsigned f2o(float f) { unsigned u = __float_as_uint(f); return u ^ ((u >> 31) ? 0xffffffffu : 0x80000000u); }
DI float o2f(unsigned u) { return __uint_as_float(u ^ ((u >> 31) ? 0x80000000u : 0xffffffffu)); }

DI void topk_compact(float* sc, unsigned short* ix, int* cntp, float* taup, int lane) {
  const int n = *cntp;
  unsigned u[8]; unsigned id[8]; bool valid[8];
#pragma unroll
  for (int i = 0; i < 8; ++i) {
    const int p = lane + 64 * i;
    valid[i] = p < n;
    u[i] = valid[i] ? f2o(sc[p]) : 0u;
    id[i] = valid[i] ? (unsigned)ix[p] : 0xffffu;
  }
  unsigned prefix = 0; int kk = 256;
  for (int bit = 31; bit >= 0; --bit) {
    const unsigned cand = (prefix >> bit) | 1u;
    int c = 0;
#pragma unroll
    for (int i = 0; i < 8; ++i) c += __popcll(__ballot(valid[i] && ((u[i] >> bit) == cand)));
    if (c >= kk) prefix |= (1u << bit); else kk -= c;
  }
  int ceq = 0;
#pragma unroll
  for (int i = 0; i < 8; ++i) ceq += __popcll(__ballot(valid[i] && u[i] == prefix));
  unsigned idthr = 0xffffu;
  if (ceq != kk) {
    unsigned p2 = 0; int k2 = kk;
    for (int bit = 13; bit >= 0; --bit) {
      int c0 = 0;
#pragma unroll
      for (int i = 0; i < 8; ++i) c0 += __popcll(__ballot(valid[i] && u[i] == prefix && ((id[i] >> bit) == (p2 >> bit))));
      if (c0 < k2) { k2 -= c0; p2 |= (1u << bit); }
    }
    idthr = p2;
  }
  int base = 0;
  const unsigned long long lt = (1ull << lane) - 1ull;
#pragma unroll
  for (int i = 0; i < 8; ++i) {
    const bool keep = valid[i] && (u[i] > prefix || (u[i] == prefix && id[i] <= idthr));
    const unsigned long long m = __ballot(keep);
    if (keep) {
      const int pos = base + __popcll(m & lt);
      sc[pos] = o2f(u[i]); ix[pos] = (unsigned short)id[i];
    }
    base += __popcll(m);
  }
  if (lane == 0) { *cntp = base; *taup = o2f(prefix); }
}

constexpr int HB_LO = 124 * 16, HB_P = 192, HB_WORDS = 387;

template <int MODE>
DI void indexer_pass(const _Float16* kbase, int ntile_in, int ts, const f16x8 (&qf)[8][2], const f16x8 (&qc)[2], const float (&wq)[8], float* csc,
                     unsigned short* cix, int* cnt, float* tau, unsigned* hist, int* oflow, int lane, int w) {
  constexpr int NG = (MODE == 2) ? 2 : 4;
  const int ntile = (ntile_in + ts - 1) / ts;
  const int q = lane & 15, kg = lane >> 4;
  const int nstep = (ntile + NG - 1) / NG;
  f16x8 cur[NG][2], nxt[NG][2];
#pragma unroll
  for (int g = 0; g < NG; ++g) {
    int tl = g; tl = tl < ntile ? tl : ntile - 1;
    cur[g][0] = *(const f16x8*)(kbase + (size_t)(tl * ts) * 64 * ZLD);
    cur[g][1] = *(const f16x8*)(kbase + (size_t)(tl * ts) * 64 * ZLD + 32);
  }
  float tq = (MODE == 0) ? 0.f : tau[q];
  for (int st = 0; st < nstep; ++st) {
#pragma unroll
    for (int g = 0; g < NG; ++g) {
      int tl = NG * (st + 1) + g; tl = tl < ntile ? tl : ntile - 1;
      nxt[g][0] = *(const f16x8*)(kbase + (size_t)(tl * ts) * 64 * ZLD);
      nxt[g][1] = *(const f16x8*)(kbase + (size_t)(tl * ts) * 64 * ZLD + 32);
    }
    if (MODE == 2) tq = tau[q];
#pragma unroll
    for (int g = 0; g < NG; ++g) {
      const int tl = NG * st + g;
      if (tl < ntile) {
        f32x4 lin = {0.f, 0.f, 0.f, 0.f};
        lin = __builtin_amdgcn_mfma_f32_16x16x32_f16(cur[g][0], qc[0], lin, 0, 0, 0);
        lin = __builtin_amdgcn_mfma_f32_16x16x32_f16(cur[g][1], qc[1], lin, 0, 0, 0);
        float s[4] = {lin[0], lin[1], lin[2], lin[3]};
        f32x4 accp = {0.f, 0.f, 0.f, 0.f};
        accp = __builtin_amdgcn_mfma_f32_16x16x32_f16(cur[g][0], qf[0][0], accp, 0, 0, 0);
        accp = __builtin_amdgcn_mfma_f32_16x16x32_f16(cur[g][1], qf[0][1], accp, 0, 0, 0);
#pragma unroll
        for (int h = 0; h < 8; ++h) {
          f32x4 accn = {0.f, 0.f, 0.f, 0.f};
          if (h < 7) {
            accn = __builtin_amdgcn_mfma_f32_16x16x32_f16(cur[g][0], qf[h + 1][0], accn, 0, 0, 0);
            accn = __builtin_amdgcn_mfma_f32_16x16x32_f16(cur[g][1], qf[h + 1][1], accn, 0, 0, 0);
          }
          __builtin_amdgcn_sched_barrier(0);
#pragma unroll
          for (int r = 0; r < 4; ++r) {
            s[r] = fmaf(wq[h], __builtin_fabsf(accp[r]), s[r]);
            asm("" : "+v"(s[r]));
          }
          __builtin_amdgcn_sched_barrier(0);
          accp = accn;
        }
        if (MODE == 0) {
#pragma unroll
          for (int r = 0; r < 4; ++r) {
            const float score = s[r] + 0.f;
            const unsigned bits = __float_as_uint(score);
            int p = (int)((bits & 0x7fffffffu) >> 19) - (HB_LO - 1);
            p = p < 0 ? 0 : (p > HB_P ? HB_P : p);
            const int bin = (bits >> 31) ? (HB_P - p) : (HB_P + 1 + p);
            atomicAdd(hist + q * HB_WORDS + bin, 1u);
          }
        } else {
          float sc4[4]; bool ps[4]; int np = 0;
#pragma unroll
          for (int r = 0; r < 4; ++r) { sc4[r] = s[r] + 0.f; ps[r] = sc4[r] > tq; np += ps[r] ? 1 : 0; }
          if (__ballot(np > 0)) {
            int pos = q * 512 + atomicAdd(&cnt[q], np);
            const int lim = q * 512 + 512;
            if (MODE != 2) { if (__ballot(pos + np > lim)) { if (pos + np > lim) *oflow = 1; } }
            const int dummy = 16 * 512 + lane;
            const unsigned kbase16 = (unsigned)(tl * 64 + w * 16 + kg * 4);
#pragma unroll
            for (int r = 0; r < 4; ++r) {
              const bool ok = ps[r] && (MODE == 2 || pos < lim);
              const int idx = ok ? pos : dummy;
              csc[idx] = sc4[r];
              cix[idx] = (unsigned short)(kbase16 + r);
              pos += ps[r] ? 1 : 0;
            }
          }
        }
      }
    }
    if (MODE == 2) {
      __syncthreads();
#pragma unroll 1
      for (int jj = 0; jj < 4; ++jj) {
        const int qq = w * 4 + jj;
        if (cnt[qq] > 384) topk_compact(csc + qq * 512, cix + qq * 512, cnt + qq, tau + qq, lane);
      }
      __syncthreads();
    }
#pragma unroll
    for (int g = 0; g < NG; ++g) { cur[g][0] = nxt[g][0]; cur[g][1] = nxt[g][1]; }
  }
}

DI void phase_indexer(const Params& P, int layer, char* smem, unsigned xcc) {
  float* csc = (float*)(smem);
  unsigned short* cix = (unsigned short*)(smem + 34816);
  unsigned* hist = (unsigned*)(smem);
  int* cnt = (int*)(smem + 52224);
  float* tau = (float*)(cnt + 16);
  int* oflow = cnt + 32;
  const int tid = ltid(), lane = tid & 63, w = tid >> 6;
  const _Float16* Zh = (const _Float16*)(P.ws + OFF_Z);
  unsigned* mask = (unsigned*)(P.ws + OFF_MASK);
  unsigned* ctr = (unsigned*)(P.ws + OFF_CTR) + (2 + layer) * 8 * 16;
  volatile int* slot = (volatile int*)(smem + 65528);
  for (int dq = 0; dq < 8; ++dq)
  for (;;) {
    const int qx = (int)((xcc + dq) & 7u);
    __syncthreads();
    if (tid == 0) *slot = (int)atomicAdd(ctr + qx * 16, 1u);
    __syncthreads();
    const int r = *slot;
    if (r >= 256) break;
    const int c = 255 - r;
    const int b = qx >> 2, qsub = qx & 3;
    const int t0 = b * S_ + c * 64 + qsub * 16;
    if (c < 4) {
      if (tid < 2 * (c + 1) * 16) {
        const int kb = tid >> 4, ql = qsub * 16 + (tid & 15);
        mask[mask_base(b, c) + kb * 64 + ql] = 0xffffffffu;
      }
      continue;
    }
    const int q = lane & 15, kg = lane >> 4;
    f16x8 qf[8][2];
#pragma unroll
    for (int h = 0; h < 8; ++h)
#pragma unroll
      for (int ks = 0; ks < 2; ++ks)
        qf[h][ks] = *(const f16x8*)(Zh + (size_t)(t0 + q) * ZLD + C_QI + h * 64 + ks * 32 + kg * 8);
    float wq[8];
    {
      const f16x8 wv = *(const f16x8*)(Zh + (size_t)(t0 + q) * ZLD + C_WI);
#pragma unroll
      for (int h = 0; h < 8; ++h) wq[h] = (float)wv[h];
    }
    f16x8 qc[2];
#pragma unroll
    for (int ks = 0; ks < 2; ++ks)
#pragma unroll
      for (int jx = 0; jx < 8; ++jx) {
        float a = 0.f;
#pragma unroll
        for (int h = 0; h < 8; ++h) a = fmaf(wq[h], (float)qf[h][ks][jx], a);
        qc[ks][jx] = (_Float16)a;
      }
    const _Float16* kbase = Zh + (size_t)(b * S_ + w * 16 + q) * ZLD + C_KI + kg * 8;
    const int ntile = c + 1;
    for (int attempt = (ntile > 16) ? 0 : 1;; ++attempt) {
      __syncthreads();
      for (int i = tid; i < 16 * HB_WORDS; i += 256) hist[i] = 0u;
      if (tid < 16) { cnt[tid] = 0; tau[tid] = -INFINITY; }
      if (tid == 0) *oflow = 0;
      __syncthreads();
      if (attempt >= 2) {
        indexer_pass<2>(kbase, ntile, 1, qf, qc, wq, csc, cix, cnt, tau, hist, oflow, lane, w);
        break;
      }
      const int ts = attempt == 0 ? 2 : 1;
      indexer_pass<0>(kbase, ntile, ts, qf, qc, wq, csc, cix, cnt, tau, hist, oflow, lane, w);
      __syncthreads();
      if (tid < 16) {
        const int nsamp = (ntile + ts - 1) / ts;
        const int target = attempt == 0 ? (328 * nsamp + ntile - 1) / ntile : 256;
        const unsigned* hq = hist + tid * HB_WORDS;
        int cum = 0, B = 0;
        for (int bin = 2 * HB_P + 1; bin >= 0; --bin) {
          cum += (int)hq[bin];
          if (cum >= target) { B = bin; break; }
        }
        float t;
        if (B > HB_P) {
          const int p = B - HB_P - 1;
          t = (p == 0) ? -1e-30f : __uint_as_float((((unsigned)(p + HB_LO - 1)) << 19) - 1u);
        } else {
          const int p = HB_P - B;
          t = (p == HB_P) ? -INFINITY : -__uint_as_float(((unsigned)(p + HB_LO)) << 19);
        }
        tau[tid] = t;
      }
      __syncthreads();
      indexer_pass<1>(kbase, ntile, 1, qf, qc, wq, csc, cix, cnt, tau, hist, oflow, lane, w);
      __syncthreads();
      if (tid < 16 && cnt[tid] < 256) *oflow = 1;
      __syncthreads();
      if (!*oflow) break;
    }
#pragma unroll 1
    for (int jj = 0; jj < 4; ++jj) {
      const int qq = w * 4 + jj;
      if (cnt[qq] > 256) topk_compact(csc + qq * 512, cix + qq * 512, cnt + qq, tau + qq, lane);
      unsigned* mrow = mask + mask_base(b, c) + (qsub * 16 + qq);
#pragma unroll
      for (int i = 0; i < 4; ++i) {
        const unsigned key = cix[qq * 512 + lane + 64 * i];
        atomicOr(mrow + (key >> 5) * 64, 1u << (key & 31));
      }
    }
    __syncthreads();
  }
}

DI int t5_bucket(int rel) {
  const int n = rel < 0 ? -rel : rel;
  int bkt;
  if (n < 8) bkt = n; else if (n < 12) bkt = 8; else if (n < 16) bkt = 9; else if (n < 23) bkt = 10; else if (n < 32) bkt = 11;
  else if (n < 46) bkt = 12; else if (n < 64) bkt = 13; else if (n < 91) bkt = 14; else bkt = 15;
  return bkt + (rel > 0 ? 16 : 0);
}

template <int DQK, bool MIXA, bool PIPE>
DI void attn_item(const Params& P, int layer, char* smem, int b, int h, int qt) {
  constexpr int NS = DQK / 16;
  constexpr int KCH = DQK / 8;
  constexpr int KROWB = DQK * 2;
  constexpr int KTILE_B = 64 * KROWB;
  constexpr int STG_B = 20480;
  constexpr int NKI = KTILE_B / 4096;
  float* biasT = (float*)(smem + 2 * STG_B);
  const int tid = ltid(), lane = tid & 63, w = tid >> 6;
  const int H = lane >> 5, l31 = lane & 31;
  const unsigned short* Z = (const unsigned short*)(P.ws + OFF_Z);
  const unsigned short *Qp, *Kp, *VT;
  int ldq, ldk;
  unsigned short* Yp = (unsigned short*)(P.ws + OFF_Z);
  if (MIXA) {
    Qp = Z + C_QA + h * 64; Kp = Z + C_KA + h * 64 + (size_t)b * S_ * ZLD; ldq = ZLD; ldk = ZLD;
    VT = (const unsigned short*)(P.ws + OFF_VTA) + (size_t)((b * 8 + h) * 64) * S_;
    Yp += C_VA + h * 64;
  } else {
    Qp = (const unsigned short*)(P.ws + OFF_QB) + h * 96; ldq = 768;
    Kp = (const unsigned short*)(P.ws + OFF_KB) + (size_t)(b * 8 + h) * S_ * 96; ldk = 96;
    VT = (const unsigned short*)(P.ws + OFF_VTB) + (size_t)((b * 8 + h) * 64) * S_;
    Yp += C_QI + h * 64;
  }
  const unsigned* mask = (const unsigned*)(P.ws + OFF_MASK);
  const int tq0 = qt * 128 + w * 32;
  const int qpos = tq0 + l31;
  const int cw = tq0 >> 6;
  const size_t tokq = (size_t)b * S_ + qpos;
  const float sl2 = (MIXA ? 0.125f : 0.10206207261596575f) * LOG2E;
  float mfix;
  {
    const float* g1 = MIXA ? (P.a_q_norm + layer * 64) : (P.b_q_norm + layer * 96);
    const float* g2 = MIXA ? (P.a_k_norm + layer * 64) : (P.b_k_norm + layer * 96);
    float a1 = 0.f, a2 = 0.f;
    for (int i = 0; i < DQK; ++i) { a1 = fmaxf(a1, fabsf(g1[i])); a2 = fmaxf(a2, fabsf(g2[i])); }
    mfix = (float)DQK * 1.02f * a1 * a2 * sl2;
    if (MIXA) {
      const float b15 = P.rel_bias[15 * 8 + h];
      float bm = 0.f;
      for (int i = 0; i < 32; ++i) bm = fmaxf(bm, P.rel_bias[i * 8 + h] - b15);
      mfix += bm * LOG2E;
    }
  }
  if (MIXA) {
    const int rel = tid - 192;
    const float b15 = P.rel_bias[15 * 8 + h];
    biasT[tid] = (P.rel_bias[t5_bucket(rel) * 8 + h] - b15) * LOG2E;
  }
  bf16x8 qf[NS];
#pragma unroll
  for (int s = 0; s < NS; ++s) qf[s] = *(const bf16x8*)(Qp + tokq * ldq + 16 * s + 8 * H);
  const int nkt = 2 * qt + 2;
  unsigned koff[NKI], voff[2];
#pragma unroll
  for (int i = 0; i < NKI; ++i) {
    const int e = (w * NKI + i) * 64 + lane;
    const int row = e / KCH, slot = e % KCH;
    const int c = slot ^ (MIXA ? ((row >> 1) & 7) : ((row >> 2) & 3));
    koff[i] = (unsigned)((row * ldk + c * 8) * 2);
  }
#pragma unroll
  for (int i = 0; i < 2; ++i) {
    const int e = (w * 2 + i) * 64 + lane;
    const int row = e >> 3, slot = e & 7;
    const int c = slot ^ ((row >> 1) & 7);
    voff[i] = (unsigned)((row * S_ + c * 8) * 2);
  }
  unsigned mwn[2] = {0u, 0u};
  auto issue_loads = [&](int kt) __attribute__((always_inline)) {
    const char* kbp = (const char*)(Kp + (size_t)(kt * 64) * ldk);
    const char* vbp = (const char*)(VT + kt * 64);
    char* sk = smem + (kt & 1) * STG_B;
#pragma unroll
    for (int i = 0; i < NKI; ++i)
      __builtin_amdgcn_global_load_lds((const unsigned*)(kbp + koff[i]), (unsigned*)(sk + (w * NKI + i) * 1024), 16, 0, 0);
#pragma unroll
    for (int i = 0; i < 2; ++i)
      __builtin_amdgcn_global_load_lds((const unsigned*)(vbp + voff[i]), (unsigned*)(sk + KTILE_B + (w * 2 + i) * 1024), 16, 0, 0);
    if (MIXA) {
      if (kt <= cw) {
        const unsigned* mp = mask + mask_base(b, cw) + (2 * kt) * 64 + (qpos & 63);
        mwn[0] = mp[0]; mwn[1] = mp[64];
      }
    }
  };
  issue_loads(0);
  f32x16 o[2];
#pragma unroll
  for (int d = 0; d < 2; ++d)
#pragma unroll
    for (int i = 0; i < 16; ++i) o[d][i] = 0.f;
  float l = 0.f;
  const int pr = (l31 & ~12) | ((l31 & 4) << 1) | ((l31 & 8) >> 1);
  const int swk = MIXA ? ((pr >> 1) & 7) : ((pr >> 2) & 3), swv = (l31 >> 1) & 7;
  asm volatile("s_waitcnt vmcnt(0)" ::: "memory");
  __syncthreads();
  for (int kt = 0; kt < nkt; ++kt) {
    unsigned mw[2] = {mwn[0], mwn[1]};
    if (kt + 1 < nkt) issue_loads(kt + 1);
    const char* Ks = smem + (kt & 1) * STG_B;
    const char* Vs = Ks + KTILE_B;
    if (kt <= cw) {
      const int kc = kt;
      bf16x8 kf[2][NS];
#pragma unroll
      for (int kb = 0; kb < 2; ++kb)
#pragma unroll
        for (int s = 0; s < NS; ++s) kf[kb][s] = *(const bf16x8*)(Ks + (32 * kb + pr) * KROWB + (((2 * s + H) ^ swk) << 4));
      __builtin_amdgcn_sched_barrier(0);
      f32x16 sacc[2];
#pragma unroll
      for (int kb = 0; kb < 2; ++kb)
#pragma unroll
        for (int i = 0; i < 16; ++i) sacc[kb][i] = 0.f;
#pragma unroll
      for (int s = 0; s < NS; ++s) sacc[0] = __builtin_amdgcn_mfma_f32_32x32x16_bf16(kf[0][s], qf[s], sacc[0], 0, 0, 0);
      bf16x8 vf[2][2][2];
#pragma unroll
      for (int d = 0; d < 2; ++d)
#pragma unroll
        for (int kb = 0; kb < 2; ++kb)
#pragma unroll
          for (int s2 = 0; s2 < 2; ++s2)
            vf[d][kb][s2] = *(const bf16x8*)(Vs + (d * 32 + l31) * 128 + (((4 * kb + 2 * s2 + H) ^ swv) << 4));
      __builtin_amdgcn_sched_barrier(0);
      const bool near = MIXA && (kc >= cw - 2);
      f32x2 ls2 = {0.f, 0.f};
      const f32x2 sl2v = {sl2, sl2}, mfixv = {mfix, mfix};
      unsigned pkw[2][2][4];
      unsigned mrot[2];
#pragma unroll
      for (int kb = 0; kb < 2; ++kb) mrot[kb] = MIXA ? ((mw[kb] >> (8 * H)) << 8) : 0u;
      auto chunk = [&](int kb, int c) __attribute__((always_inline)) {
        const int s2 = 1 - (c >> 2), e = 3 - (c & 3);
        const int r0 = 8 * s2 + 2 * e;
        if (MIXA && c == 4) mrot[kb] <<= 8;
        f32x2 xv2 = {sacc[kb][r0], sacc[kb][r0 + 1]};
        xv2 = xv2 * sl2v - mfixv;
        if (MIXA) {
          if (near) {
            const int kl = 16 * (r0 >> 3) + 8 * H + (r0 & 7);
            const int rel = kc * 64 + 32 * kb + kl - qpos;
            xv2.x += biasT[rel + 192];
            xv2.y += biasT[rel + 193];
          }
        }
        f32x2 p2 = {__builtin_amdgcn_exp2f(xv2.x), __builtin_amdgcn_exp2f(xv2.y)};
        if (MIXA) {
          float px = p2.x, py = p2.y;
          asm volatile("v_add_co_u32 %0, vcc, %0, %0\n\tv_cndmask_b32 %1, 0, %1, vcc" : "+v"(mrot[kb]), "+v"(py) : : "vcc");
          asm volatile("v_add_co_u32 %0, vcc, %0, %0\n\tv_cndmask_b32 %1, 0, %1, vcc" : "+v"(mrot[kb]), "+v"(px) : : "vcc");
          p2.x = px; p2.y = py;
        }
        ls2 += p2;
        pkw[kb][s2][e] = pk2(p2.x, p2.y);
      };
      {
        int c0 = 0;
#pragma unroll
        for (int s = 0; s < NS; ++s) {
          sacc[1] = __builtin_amdgcn_mfma_f32_32x32x16_bf16(kf[1][s], qf[s], sacc[1], 0, 0, 0);
          const int cend = (8 * (s + 1)) / NS;
#pragma unroll
          for (int c = 0; c < 8; ++c) if (c >= c0 && c < cend) chunk(0, c);
          c0 = cend;
          __builtin_amdgcn_sched_barrier(0);
        }
      }
      bf16x8 pf0[2], pf1[2];
#pragma unroll
      for (int s2 = 0; s2 < 2; ++s2) { u32x4 t = {pkw[0][s2][0], pkw[0][s2][1], pkw[0][s2][2], pkw[0][s2][3]}; pf0[s2] = __builtin_bit_cast(bf16x8, t); }
#pragma unroll
      for (int j = 0; j < 4; ++j) {
        const int s2 = j >> 1, d = j & 1;
        o[d] = __builtin_amdgcn_mfma_f32_32x32x16_bf16(vf[d][0][s2], pf0[s2], o[d], 0, 0, 0);
        chunk(1, 2 * j); chunk(1, 2 * j + 1);
        __builtin_amdgcn_sched_barrier(0);
      }
#pragma unroll
      for (int s2 = 0; s2 < 2; ++s2) { u32x4 t = {pkw[1][s2][0], pkw[1][s2][1], pkw[1][s2][2], pkw[1][s2][3]}; pf1[s2] = __builtin_bit_cast(bf16x8, t); }
#pragma unroll
      for (int j = 0; j < 4; ++j) {
        const int s2 = j >> 1, d = j & 1;
        o[d] = __builtin_amdgcn_mfma_f32_32x32x16_bf16(vf[d][1][s2], pf1[s2], o[d], 0, 0, 0);
      }
      l += ls2.x + ls2.y;
    }
    asm volatile("s_waitcnt vmcnt(0)" ::: "memory");
    __syncthreads();
  }
  const float lt = l + __shfl_xor(l, 32);
  const float inv = 1.f / lt;
  unsigned short* yr = Yp + tokq * ZLD;
#pragma unroll
  for (int d = 0; d < 2; ++d)
#pragma unroll
    for (int g = 0; g < 4; ++g) {
      u32x2 ov;
      ov.x = pk2(o[d][4 * g] * inv, o[d][4 * g + 1] * inv);
      ov.y = pk2(o[d][4 * g + 2] * inv, o[d][4 * g + 3] * inv);
      *(u32x2*)(yr + d * 32 + 8 * g + 4 * H) = ov;
    }
}

#ifndef PIPE_MLA
#define PIPE_MLA false
#endif
#ifndef PIPE_MIXA
#define PIPE_MIXA false
#endif
DI void phase_attention(const Params& P, int layer, char* smem, unsigned xcc) {
  unsigned* ctr = (unsigned*)(P.ws + OFF_CTR) + layer * 8 * 16;
  volatile int* slot = (volatile int*)(smem + 65528);
  const int tid = ltid();
  for (int d = 0; d < 8; ++d) {
    const int h = (int)((xcc + d) & 7u);
    for (;;) {
      if (tid == 0) *slot = (int)atomicAdd(ctr + h * 16, 1u);
      __syncthreads();
      const int r = *slot;
      __syncthreads();
      if (r >= 512) break;
      const int qt = 127 - (r & 127);
      const int mixer = (r >> 8) & 1, b = (r >> 7) & 1;
      if (mixer) attn_item<96, false, PIPE_MLA>(P, layer, smem, b, h, qt);
      else attn_item<64, true, PIPE_MIXA>(P, layer, smem, b, h, qt);
    }
  }
}

DI float sigmoidf_(float v) { return __builtin_amdgcn_rcpf(1.f + __expf(-v)); }

DI void phase_merge(const Params& P, int layer, char* smem) {
  const bf16* hn = (const bf16*)(P.ws + OFF_HN);
  const bf16* Z = (const bf16*)(P.ws + OFF_Z);
  const bf16* wl = (const bf16*)(P.ws + OFF_WT) + layer * W_LAYER;
  unsigned short* MG = (unsigned short*)(P.ws + OFF_QB);
  unsigned short* TG = (unsigned short*)(P.ws + OFF_VTA);
  const float* bg = P.b_gate + layer * 2048;
  for (int t0 = blockIdx.x; t0 < 256 * 8; t0 += gridDim.x) {
    const int t = xcd_tile(t0, 256 * 8);
    const int m0 = (t >> 3) * 128, n0 = (t & 7) * 128;
#pragma unroll 1
    for (int step = 0; step < 4; ++step) {
      f32x16 acc[2][2];
      const bool gate = step < 2;
      const bf16* A = gate ? hn : (Z + (step == 2 ? C_VA : C_QI));
      const bf16* Bt = wl + (step == 0 ? WO_IN + (size_t)C_GA * 1024 : step == 1 ? WO_IN + (size_t)C_GB * 1024 : step == 2 ? WO_PA : WO_PB);
      gemm_tile(smem, gate ? 16 : 8, A, gate ? 1024 : ZLD, m0, Bt, gate ? 1024 : 512, n0, acc);
      if (gate) {
        unsigned short* dst = step == 0 ? MG : TG;
        const float* bgs = bg + (step == 0 ? 0 : 1024);
        unsigned short* Cs = (unsigned short*)smem;
        epi_foreach(acc, [&](int row, int col, float v) __attribute__((always_inline)) {
          Cs[row * 136 + col] = f2bf(sigmoidf_(v + bgs[n0 + col]));
        });
        __syncthreads();
        store_tile16(Cs, dst + (size_t)m0 * 1024 + n0, 1024);
        __syncthreads();
      } else {
        unsigned short* Cs = (unsigned short*)smem;
        epi_foreach(acc, [&](int row, int col, float v) __attribute__((always_inline)) { Cs[row * 136 + col] = f2bf(v); });
        __syncthreads();
        const int tid_ = ltid();
#pragma unroll 2
        for (int i = 0; i < 8; ++i) {
          const int idx = tid_ + 256 * i;
          const int row = idx >> 4, c8 = (idx & 15) * 8;
          u32x4* gp = (u32x4*)(MG + (size_t)(m0 + row) * 1024 + n0 + c8);
          const u32x4 mg = *gp;
          const u32x4 pj = *(const u32x4*)(Cs + row * 136 + c8);
          u32x4 ov;
          if (step == 2) {
#pragma unroll
            for (int e = 0; e < 4; ++e) ov[e] = pk2(bflo(mg[e]) * bflo(pj[e]), bfhi(mg[e]) * bfhi(pj[e]));
          } else {
            const u32x4 tg = *(const u32x4*)(TG + (size_t)(m0 + row) * 1024 + n0 + c8);
#pragma unroll
            for (int e = 0; e < 4; ++e) ov[e] = pk2(bflo(mg[e]) + bflo(tg[e]) * bflo(pj[e]), bfhi(mg[e]) + bfhi(tg[e]) * bfhi(pj[e]));
          }
          *gp = ov;
        }
        __syncthreads();
      }
    }
  }
}

DI void phase_out(const Params& P, int layer, const float* xin, char* smem) {
  const bf16* MG = (const bf16*)(P.ws + OFF_QB);
  const bf16* wl = (const bf16*)(P.ws + OFF_WT) + layer * W_LAYER;
  const int lane = ltid() & 63, w = ltid() >> 6;
  const int wm = w >> 1, wn = w & 1;
  for (int t0 = blockIdx.x; t0 < 256 * 8; t0 += gridDim.x) {
    const int t = xcd_tile(t0, 256 * 8);
    const int m0 = (t >> 3) * 128, n0 = (t & 7) * 128;
    f32x16 acc[2][2];
    float xr[2][2][16];
    const unsigned obase_b = 4u * (unsigned)((m0 + wm * 64 + 4 * (lane >> 5)) * 1024 + n0 + wn * 64 + (lane & 31));
#pragma unroll
    for (int mb = 0; mb < 2; ++mb)
#pragma unroll
      for (int nb = 0; nb < 2; ++nb)
#pragma unroll
        for (int r = 0; r < 16; ++r) xr[mb][nb][r] = (*uoff(xin + ((mb * 32 + (r & 3) + 8 * (r >> 2)) * 1024 + nb * 32), obase_b));
    gemm_tile(smem, 16, MG, 1024, m0, wl + WO_OUT, 1024, n0, acc);
#pragma unroll
    for (int mb = 0; mb < 2; ++mb)
#pragma unroll
      for (int nb = 0; nb < 2; ++nb)
#pragma unroll
        for (int r = 0; r < 16; ++r)
          (*uoff(P.out + ((mb * 32 + (r & 3) + 8 * (r >> 2)) * 1024 + nb * 32), obase_b)) = xr[mb][nb][r] + acc[mb][nb][r];
  }
}

DI void phase_up(const Params& P, int layer, char* smem) {
  const bf16* hn = (const bf16*)(P.ws + OFF_HN);
  const bf16* wup = (const bf16*)(P.ws + OFF_WT) + layer * W_LAYER + WO_UP;
  unsigned short* ACT = (unsigned short*)(P.ws + OFF_Z);
  const float* cw = P.conv_w + (size_t)layer * 3 * 5632;
  const float* cb = P.conv_b + (size_t)layer * 5632;
  unsigned short* Cs = (unsigned short*)smem;
  const int tid = ltid();
  constexpr int MT = 262, NT = 44;
  for (int t0 = blockIdx.x; t0 < MT * NT; t0 += gridDim.x) {
    const int tl = xcd_tile(t0, MT * NT) - (t0 & 7) * ((MT * NT) >> 3);
    const int mt = (t0 & 1) * 131 + tl / 11, nt = ((t0 & 7) >> 1) * 11 + tl % 11;
    const int b = mt / 131, i = mt % 131;
    const int tb0 = i * 126 - 2;
    unsigned aoff[4], boff[4];
    const char* Abase = (const char*)(hn + (size_t)b * S_ * 1024);
    const unsigned zoff = (unsigned)((P.ws + OFF_ZPAGE) - Abase);
#pragma unroll
    for (int q = 0; q < 4; ++q) {
      const int r = glds_row(q), ch = glds_chunk(r);
      const int tb = tb0 + r;
      const bool ok = (tb >= 0) && (tb < S_);
      aoff[q] = ok ? (unsigned)((tb * 1024 + ch * 8) * 2) : zoff;
      const int wr = (r < 64) ? (nt * 64 + r) : (DFF + nt * 64 + r - 64);
      boff[q] = (unsigned)((wr * 1024 + ch * 8) * 2);
    }
    f32x16 acc[2][2];
    gemm_core(smem, 16, Abase, (const char*)wup, aoff, boff, acc);
    epi_foreach(acc, [&](int row, int col, float v) __attribute__((always_inline)) { Cs[row * 136 + col] = f2bf(v); });
    __syncthreads();
    {
      const int col = tid & 63, rb = tid >> 6;
      const int cv = nt * 64 + col, cg_ = DFF + nt * 64 + col;
      const float w0v = cw[cv], w1v = cw[5632 + cv], w2v = cw[2 * 5632 + cv], bv = cb[cv];
      const float w0g = cw[cg_], w1g = cw[5632 + cg_], w2g = cw[2 * 5632 + cg_], bgt = cb[cg_];
      for (int r = 2 + rb; r < 128; r += 4) {
        const int tb = tb0 + r;
        if (tb < S_) {
          const float val = bv + w0v * bf2f(Cs[(r - 2) * 136 + col]) + w1v * bf2f(Cs[(r - 1) * 136 + col]) + w2v * bf2f(Cs[r * 136 + col]);
          const float gat = bgt + w0g * bf2f(Cs[(r - 2) * 136 + 64 + col]) + w1g * bf2f(Cs[(r - 1) * 136 + 64 + col]) + w2g * bf2f(Cs[r * 136 + 64 + col]);
          const float a = gat / (1.f + __expf(-gat)) * val;
          ACT[(size_t)(b * S_ + tb) * DFF + cv] = f2bf(a);
        }
      }
    }
    __syncthreads();
  }
}

DI void phase_down(const Params& P, int layer, char* smem) {
  const bf16* ACT = (const bf16*)(P.ws + OFF_Z);
  const bf16* wl = (const bf16*)(P.ws + OFF_WT) + layer * W_LAYER;
  const int lane = ltid() & 63, w = ltid() >> 6;
  const int wm = w >> 1, wn = w & 1;
  for (int t0 = blockIdx.x; t0 < 256 * 8; t0 += gridDim.x) {
    const int t = xcd_tile(t0, 256 * 8);
    const int m0 = (t >> 3) * 128, n0 = (t & 7) * 128;
    f32x16 acc[2][2];
    float xr[2][2][16];
    const float* xld = P.out; asm volatile("" : "+s"(xld));
    const unsigned obase_b = 4u * (unsigned)((m0 + wm * 64 + 4 * (lane >> 5)) * 1024 + n0 + wn * 64 + (lane & 31));
#pragma unroll
    for (int mb = 0; mb < 2; ++mb)
#pragma unroll
      for (int nb = 0; nb < 2; ++nb)
#pragma unroll
        for (int r = 0; r < 16; ++r) xr[mb][nb][r] = (*uoff(xld + ((mb * 32 + (r & 3) + 8 * (r >> 2)) * 1024 + nb * 32), obase_b));
    gemm_tile(smem, 44, ACT, DFF, m0, wl + WO_DOWN, DFF, n0, acc);
    float* xst = P.out; asm volatile("" : "+s"(xst));
#pragma unroll
    for (int mb = 0; mb < 2; ++mb)
#pragma unroll
      for (int nb = 0; nb < 2; ++nb)
#pragma unroll
        for (int r = 0; r < 16; ++r)
          (*uoff(xst + ((mb * 32 + (r & 3) + 8 * (r >> 2)) * 1024 + nb * 32), obase_b)) = xr[mb][nb][r] + acc[mb][nb][r];
  }
}

#define XB_TMO      128
#define XB_XCNT(j)  (256  + 64 * (j))
#define XB_XSUB(j)  (1280 + 64 * (j))
#define XB_XGEN(j)  (2304 + 64 * (j))
#define XB_TOP      3328
#define XB_TOPGEN   3392
#define XCD_BAR_WORDS 3456
#define XB_SPIN_CAP (1u << 22)
#define LAS __attribute__((address_space(3)))
DI unsigned xb_ld(unsigned* p)              { return __hip_atomic_load(p, __ATOMIC_RELAXED, __HIP_MEMORY_SCOPE_AGENT); }
DI unsigned xb_add(unsigned* p, unsigned v) { return __hip_atomic_fetch_add(p, v, __ATOMIC_RELAXED, __HIP_MEMORY_SCOPE_AGENT); }
DI unsigned xb_xcc_id() { return (unsigned)__builtin_amdgcn_s_getreg((3 << 11) | 20) & 0xFu; }
#define XB_SPIN(cond, bar) do { unsigned _sp = 0; while (cond) { __builtin_amdgcn_s_sleep(1); \
    if ((++_sp & 255u) == 0u) { if (xb_ld(&(bar)[XB_TMO])) break; if (_sp > XB_SPIN_CAP) { atomicAdd(&(bar)[XB_TMO], 1u); break; } } } } while (0)
struct XcdBarrier { unsigned* bar; unsigned x; unsigned nloc, nx; };
DI XcdBarrier xcd_barrier_post(unsigned* bar) {
  XcdBarrier b; b.bar = bar; b.x = xb_xcc_id(); b.nloc = 0u; b.nx = 0u;
  if (threadIdx.x == 0) (void)xb_add(&bar[XB_XCNT(b.x)], 1u);
  return b;
}
DI void xcd_barrier_complete(unsigned* bar, unsigned x, unsigned& nloc, unsigned& nx) {
  const unsigned G = gridDim.x * gridDim.y * gridDim.z;
  unsigned sum, cnt, mine, sp = 0u;
  for (;;) {
    sum = 0u; cnt = 0u; mine = 0u;
#pragma unroll
    for (unsigned j = 0; j < 16; ++j) { const unsigned c = xb_ld(&bar[XB_XCNT(j)]); sum += c; cnt += (c > 0u) ? 1u : 0u; mine = (j == x) ? c : mine; }
    if (sum == G) break;
    __builtin_amdgcn_s_sleep(1);
    if ((++sp & 255u) == 0u) { if (xb_ld(&bar[XB_TMO])) break; if (sp > XB_SPIN_CAP) { atomicAdd(&bar[XB_TMO], 1u); break; } }
  }
  nloc = mine > 0u ? mine : 1u; nx = cnt > 0u ? cnt : 1u;
}
DI void xcd_barrier(XcdBarrier& b) {
  asm volatile("s_waitcnt vmcnt(0)" ::: "memory");
  __syncthreads();
  if (threadIdx.x == 0) {
    unsigned* bar = b.bar;
    __builtin_amdgcn_s_waitcnt(0);
    unsigned nloc = b.nloc, nx = b.nx;
    if (nloc == 0u) { xcd_barrier_complete(bar, b.x, nloc, nx); b.nloc = nloc; b.nx = nx; }
    const unsigned old = xb_add(&bar[XB_XSUB(b.x)], 1u);
    const unsigned gen = old / nloc;
    if (old + 1u == (gen + 1u) * nloc) {
      __builtin_amdgcn_fence(__ATOMIC_RELEASE, "agent");
      asm volatile("s_waitcnt vmcnt(0)" ::: "memory");
      const unsigned og = xb_add(&bar[XB_TOP], 1u);
      const unsigned tg = og / nx;
      if (og + 1u == (tg + 1u) * nx) xb_add(&bar[XB_TOPGEN], 1u);
      else XB_SPIN(xb_ld(&bar[XB_TOPGEN]) == tg, bar);
      __builtin_amdgcn_fence(__ATOMIC_ACQUIRE, "agent");
      xb_add(&bar[XB_XGEN(b.x)], 1u);
      asm volatile("s_waitcnt vmcnt(0)" ::: "memory");
    } else {
      XB_SPIN(xb_ld(&bar[XB_XGEN(b.x)]) == gen, bar);
      __builtin_amdgcn_fence(__ATOMIC_ACQUIRE, "agent");
      asm volatile("s_waitcnt vmcnt(0)" ::: "memory");
    }
  }
  __syncthreads();
}

constexpr int PH_PER_LAYER = 11;
constexpr int NPHASES = 2 * PH_PER_LAYER;

DI void run_phase(const Params& P, int ph, char* smem, unsigned xcc) {
  const int layer = ph / PH_PER_LAYER, p = ph % PH_PER_LAYER;
  const float* xin = layer == 0 ? P.x : P.out;
  bf16* HN = (bf16*)(P.ws + OFF_HN);
  switch (p) {
    case 0:
      if (layer == 0) phase_convert(P, smem);
      phase_zero_mask(P);
      phase_rmsnorm(xin, P.norm_mix + layer * 1024, HN);
      break;
    case 1: phase_gemm_in(P, layer, smem); break;
    case 2: phase_token_a(P, layer, smem); break;
    case 3: phase_gemm_lat(P, layer, smem); break;
    case 4: phase_token_c(P, layer, smem); phase_indexer(P, layer, smem, xcc); break;
    case 5: phase_attention(P, layer, smem, xcc); if (layer != 0) phase_rmsnorm(xin, P.norm_mix + layer * 1024, HN); break;
    case 6: phase_merge(P, layer, smem); break;
    case 7: phase_out(P, layer, xin, smem); break;
    case 8: phase_rmsnorm(P.out, P.norm_ffn + layer * 1024, HN); break;
    case 9: phase_up(P, layer, smem); break;
    case 10: phase_down(P, layer, smem); break;
  }
}

__global__ void __launch_bounds__(256, 2) mega_kernel(Params P, int ph_begin, int ph_end) {
  __shared__ __attribute__((aligned(1024))) char smem[65536];
  cg::grid_group grid = cg::this_grid();
  XcdBarrier xb = xcd_barrier_post((unsigned*)(P.ws + OFF_BAR));
  for (int ph = ph_begin; ph < ph_end; ++ph) {
    run_phase(P, ph, smem, xb.x);
    if (ph + 1 < ph_end) {
      if (ph_end > 1000) grid.sync();
      else xcd_barrier(xb);
    }
  }
}

extern "C" void kernel_launch(void* const* d_in, const int* in_sizes, int n_in, void* d_out, int out_size, void* d_ws,
                              size_t ws_size, hipStream_t stream) {
  Params P{};
  P.x = (const float*)d_in[0]; P.rel_bias = (const float*)d_in[1]; P.norm_mix = (const float*)d_in[2];
  P.w_in = (const float*)d_in[3]; P.a_q_norm = (const float*)d_in[4]; P.a_k_norm = (const float*)d_in[5];
  P.b_cq_norm = (const float*)d_in[6]; P.b_ckv_norm = (const float*)d_in[7]; P.b_w_uq = (const float*)d_in[8];
  P.b_w_ukv = (const float*)d_in[9]; P.b_q_norm = (const float*)d_in[10]; P.b_k_norm = (const float*)d_in[11];
  P.w_proj_a = (const float*)d_in[12]; P.w_proj_b = (const float*)d_in[13]; P.b_gate = (const float*)d_in[14];
  P.w_out = (const float*)d_in[15]; P.norm_ffn = (const float*)d_in[16]; P.w_up = (const float*)d_in[17];
  P.conv_w = (const float*)d_in[18]; P.conv_b = (const float*)d_in[19]; P.w_down = (const float*)d_in[20];
  P.out = (float*)d_out; P.ws = (char*)d_ws;
  static int grid_blocks = 0;
  if (!grid_blocks) {
    int dev = 0, cus = 0, per_cu = 0;
    hipGetDevice(&dev);
    hipDeviceGetAttribute(&cus, hipDeviceAttributeMultiprocessorCount, dev);
    hipOccupancyMaxActiveBlocksPerMultiprocessor(&per_cu, mega_kernel, 256, 0);
    if (per_cu > 2) per_cu = 2;
    if (per_cu < 1) per_cu = 1;
    grid_blocks = cus * per_cu;
  }
#if MULTI_LAUNCH
  for (int ph = 0; ph < NPHASES; ++ph) {
    hipLaunchKernelGGL(mega_kernel, dim3(grid_blocks), dim3(256), 0, stream, P, ph, ph + 1);
  }
#else
  hipMemsetAsync((char*)d_ws + OFF_BAR, 0, 65536, stream);
  int b = 0, e = NPHASES;
  void* args[] = {&P, &b, &e};
  hipError_t err = hipLaunchCooperativeKernel((void*)mega_kernel, dim3(grid_blocks), dim3(256), args, 0, stream);
  if (err != hipSuccess) fprintf(stderr, "cooperative launch failed: %s (grid %d)\n", hipGetErrorString(err), grid_blocks);
#endif
}
```
